# Optimizing an MI355X kernel written in HIP

```python
import jax, jax.numpy as jnp
from jax import lax
import numpy as np

D_MODEL = 1024
BATCH = 4
SEQ = 4096
DEPTH = 2

GRID_W = 64
CTX_LEN = 256
HEAD_DIM_A = 128
HEADS_A = D_MODEL // (2 * HEAD_DIM_A)
KV_HEADS_A = HEADS_A // 2
GROUP_A = HEADS_A // KV_HEADS_A
HEAD_DIM_B = 64
HEADS_B = D_MODEL // (2 * HEAD_DIM_B)
NA_MAX_ROWS = 8
NA_WIN_COLS = 16
Q_BLOCK = 128
FOURIER_GROUPS = 4
D_FF = 2816
CONV_W = 3
ROPE_THETA = 10000.0
ROPE_PAIRS_AXIS = HEAD_DIM_A // 4
EPS = 1e-6
QA_COLS = HEADS_A * HEAD_DIM_A
KA_COLS = KV_HEADS_A * HEAD_DIM_A
B_COLS = HEADS_B * HEAD_DIM_B
Q_COLS = QA_COLS + B_COLS
IN_COLS = Q_COLS + 2 * KA_COLS + 2 * B_COLS
MIX_WIDTH = QA_COLS + B_COLS

kernel_name = "hybrid_gqa_natten_fnet_convffn_dit"


def rmsnorm(x, g):
    xf = x.astype(jnp.float32)
    y = xf * lax.rsqrt(jnp.mean(xf * xf, axis=-1, keepdims=True) + EPS)
    return (y * g.astype(jnp.float32)).astype(x.dtype)


def adaln(vec, w, b):
    m = jax.nn.silu(vec) @ w + b
    return jnp.split(m[..., None, :], 6, axis=-1)


def modulate(h, shift, scale):
    return h * (1.0 + scale) + shift


def heads(t, n):
    return t.reshape(*t.shape[:-1], n, -1)


def axial_rope(length):
    t = jnp.arange(length)
    row = (t // GRID_W).astype(jnp.float32)
    col = (t % GRID_W).astype(jnp.float32)
    freqs = ROPE_THETA ** (-jnp.arange(ROPE_PAIRS_AXIS, dtype=jnp.float32) / ROPE_PAIRS_AXIS)
    ang = jnp.concatenate([row[:, None] * freqs, col[:, None] * freqs], axis=-1)
    return jnp.cos(ang)[:, None, :], jnp.sin(ang)[:, None, :]


def apply_rope(x, cos, sin):
    xf = x.astype(jnp.float32).reshape(*x.shape[:-1], -1, 2)
    x0, x1 = xf[..., 0], xf[..., 1]
    out = jnp.stack([x0 * cos - x1 * sin, x0 * sin + x1 * cos], axis=-1)
    return out.reshape(x.shape).astype(x.dtype)


def attend(q, k, v):
    s = jnp.einsum('bqkgd,bskd->bkgqs', q, k).astype(jnp.float32)
    p = jax.nn.softmax(s, axis=-1).astype(v.dtype)
    o = jnp.einsum('bkgqs,bskd->bqkgd', p, v)
    return o.reshape(*o.shape[:2], -1)


def gqa_blocks(q, k, v):
    bn, length = q.shape[:2]
    nb = length // Q_BLOCK
    qb = q.reshape(bn, nb, Q_BLOCK, KV_HEADS_A, GROUP_A, HEAD_DIM_A).transpose(1, 0, 2, 3, 4, 5)
    o = lax.map(lambda qi: attend(qi, k, v), qb)
    return o.transpose(1, 0, 2, 3).reshape(bn, length, -1)


def neighbourhood_attention(q, k, v, ck, cv, rpb):
    bn, length, nh, hd = q.shape
    rows = length // GRID_W
    wr = min(NA_MAX_ROWS, rows)
    grid = lambda t: t.reshape(bn, rows, GRID_W, nh, hd)
    kg, vg = grid(k), grid(v)
    r = jnp.arange(rows)
    col = jnp.arange(GRID_W)
    row_start = jnp.clip(r - wr // 2, 0, rows - wr)
    col_idx = (jnp.clip(col - NA_WIN_COLS // 2, 0, GRID_W - NA_WIN_COLS)[:, None]
               + jnp.arange(NA_WIN_COLS))
    row_off = row_start[:, None] + jnp.arange(wr) - r[:, None] + NA_MAX_ROWS - 1
    col_off = col_idx - col[:, None] + NA_WIN_COLS - 1
    n_win = wr * NA_WIN_COLS

    def row_block(args):
        q_r, r0, off_r = args
        kw = lax.dynamic_slice_in_dim(kg, r0, wr, axis=1)[:, :, col_idx]
        vw = lax.dynamic_slice_in_dim(vg, r0, wr, axis=1)[:, :, col_idx]
        bias = rpb[:, off_r][:, :, col_off].transpose(0, 2, 1, 3)
        s_win = jnp.einsum('bchd,bicjhd->bhcij', q_r, kw).astype(jnp.float32) + bias.astype(jnp.float32)
        s_ctx = jnp.einsum('bchd,bshd->bhcs', q_r, ck).astype(jnp.float32)
        s = jnp.concatenate([s_win.reshape(bn, nh, GRID_W, n_win), s_ctx], axis=-1)
        p = jax.nn.softmax(s, axis=-1).astype(v.dtype)
        p_win = p[..., :n_win].reshape(bn, nh, GRID_W, wr, NA_WIN_COLS)
        o = (jnp.einsum('bhcij,bicjhd->bchd', p_win, vw)
             + jnp.einsum('bhcs,bshd->bchd', p[..., n_win:], cv))
        return o.reshape(bn, GRID_W, nh * hd)

    o = lax.map(row_block, (grid(q).transpose(1, 0, 2, 3, 4), row_start, row_off))
    return o.transpose(1, 0, 2, 3).reshape(bn, length, nh * hd)


def attention_mixer(h, hc, w_in, w_out, q_g, k_g, rpb, ctx_out):
    bn, length, _ = h.shape
    kv_splits = [KA_COLS, 2 * KA_COLS, 2 * KA_COLS + B_COLS]
    qa, qb, ka, va, kb, vb = jnp.split(h @ w_in, [QA_COLS, Q_COLS] + [Q_COLS + s for s in kv_splits], axis=-1)
    cka, cva, ckb, cvb = jnp.split(hc @ w_in[:, Q_COLS:], kv_splits, axis=-1)
    scale_a = HEAD_DIM_A ** -0.5
    scale_b = HEAD_DIM_B ** -0.5
    cos, sin = axial_rope(length)
    qa = apply_rope(rmsnorm(heads(qa, HEADS_A), q_g), cos, sin) * scale_a
    ka = apply_rope(rmsnorm(heads(ka, KV_HEADS_A), k_g), cos, sin)
    cka = rmsnorm(heads(cka, KV_HEADS_A), k_g)
    cva = heads(cva, KV_HEADS_A)
    oa = gqa_blocks(qa, jnp.concatenate([ka, cka], axis=1),
                    jnp.concatenate([heads(va, KV_HEADS_A), cva], axis=1))
    ckb = heads(ckb, HEADS_B)
    cvb = heads(cvb, HEADS_B)
    ob = neighbourhood_attention(heads(qb, HEADS_B) * scale_b, heads(kb, HEADS_B), heads(vb, HEADS_B),
                                 ckb, cvb, rpb)
    y = jnp.concatenate([oa, ob], axis=-1) @ w_out
    if not ctx_out:
        return y, None
    cq = hc @ w_in[:, :Q_COLS]
    cqa, cqb = jnp.split(cq, [QA_COLS], axis=-1)
    cqa = (rmsnorm(heads(cqa, HEADS_A), q_g) * scale_a).reshape(*hc.shape[:2], KV_HEADS_A, GROUP_A, HEAD_DIM_A)
    coa = attend(cqa, cka, cva)
    cqb = (heads(cqb, HEADS_B) * scale_b)[:, :, :, None, :]
    cob = attend(cqb.reshape(*hc.shape[:2], HEADS_B, 1, HEAD_DIM_B), ckb, cvb)
    yc = jnp.concatenate([coa, cob], axis=-1) @ w_out
    return y, yc


def fourier_mixer(h, w_out):
    bn, length, d = h.shape
    hg = h.astype(jnp.float32).reshape(bn, length, FOURIER_GROUPS, d // FOURIER_GROUPS)
    y = jnp.fft.fft2(hg, axes=(1, 3), norm='ortho').real
    return y.reshape(bn, length, d).astype(h.dtype) @ w_out


def conv_ffn(h, w_up, conv_w, conv_b, w_down):
    u = h @ w_up
    up = jnp.pad(u, ((0, 0), (1, 1), (0, 0)))
    u = up[:, :-2] * conv_w[0] + up[:, 1:-1] * conv_w[1] + up[:, 2:] * conv_w[2] + conv_b
    g, val = jnp.split(u, 2, axis=-1)
    return (jax.nn.silu(g) * val) @ w_down


def setup_inputs(seed: int = 0) -> dict:
    key = jax.random.key(seed)
    ks = jax.random.split(key, 20)
    n_even = (DEPTH + 1) // 2
    n_odd = DEPTH // 2
    nrm = lambda k, shape, s: jax.random.normal(k, shape, jnp.float32) * s
    return {
        "x": nrm(ks[0], (BATCH, SEQ, D_MODEL), 1.0),
        "c": nrm(ks[1], (BATCH, D_MODEL), 1.0),
        "ctx": nrm(ks[2], (BATCH, CTX_LEN, D_MODEL), 1.0),
        "c_ctx": nrm(ks[3], (D_MODEL,), 1.0),
        "mod_w": nrm(ks[4], (DEPTH, D_MODEL, 6 * D_MODEL), 0.5 * D_MODEL ** -0.5),
        "mod_b": nrm(ks[5], (DEPTH, 6 * D_MODEL), 0.02),
        "norm1_g": 1.0 + nrm(ks[6], (DEPTH, D_MODEL), 0.02),
        "norm2_g": 1.0 + nrm(ks[7], (DEPTH, D_MODEL), 0.02),
        "attn_w_in": nrm(ks[8], (n_even, D_MODEL, IN_COLS), D_MODEL ** -0.5),
        "attn_w_out": nrm(ks[9], (n_even, MIX_WIDTH, D_MODEL), MIX_WIDTH ** -0.5),
        "q_norm_g": 1.0 + nrm(ks[10], (n_even, HEAD_DIM_A), 0.02),
        "k_norm_g": 1.0 + nrm(ks[11], (n_even, HEAD_DIM_A), 0.02),
        "na_rpb": nrm(ks[12], (n_even, HEADS_B, 2 * NA_MAX_ROWS - 1, 2 * NA_WIN_COLS - 1), 0.1),
        "fourier_w_out": nrm(ks[13], (n_odd, D_MODEL, D_MODEL), D_MODEL ** -0.5),
        "ffn_w_up": nrm(ks[14], (DEPTH, D_MODEL, 2 * D_FF), D_MODEL ** -0.5),
        "ffn_conv_w": nrm(ks[15], (DEPTH, CONV_W, 2 * D_FF), CONV_W ** -0.5),
        "ffn_conv_b": nrm(ks[16], (DEPTH, 2 * D_FF), 0.02),
        "ffn_w_down": nrm(ks[17], (DEPTH, D_FF, D_MODEL), D_FF ** -0.5),
        "final_g": 1.0 + nrm(ks[18], (D_MODEL,), 0.02),
    }


def reference(x, c, ctx, c_ctx, mod_w, mod_b, norm1_g, norm2_g, attn_w_in, attn_w_out, q_norm_g,
              k_norm_g, na_rpb, fourier_w_out, ffn_w_up, ffn_conv_w, ffn_conv_b, ffn_w_down, final_g):
    for i in range(DEPTH):
        ctx_live = any(j % 2 == 0 for j in range(i + 1, DEPTH))
        sh1, sc1, g1, sh2, sc2, g2 = adaln(c, mod_w[i], mod_b[i])
        h = modulate(rmsnorm(x, norm1_g[i]), sh1, sc1)
        need_hc = (i % 2 == 0) or ctx_live
        if need_hc:
            csh1, csc1, cg1, csh2, csc2, cg2 = adaln(c_ctx, mod_w[i], mod_b[i])
            hc = modulate(rmsnorm(ctx, norm1_g[i]), csh1, csc1)
        if i % 2 == 0:
            e = i // 2
            y, yc = attention_mixer(h, hc, attn_w_in[e], attn_w_out[e], q_norm_g[e], k_norm_g[e],
                                    na_rpb[e], ctx_live)
        else:
            y = fourier_mixer(h, fourier_w_out[i // 2])
            yc = fourier_mixer(hc, fourier_w_out[i // 2]) if ctx_live else None
        x = x + g1 * y
        x = x + g2 * conv_ffn(modulate(rmsnorm(x, norm2_g[i]), sh2, sc2),
                              ffn_w_up[i], ffn_conv_w[i], ffn_conv_b[i], ffn_w_down[i])
        if ctx_live:
            ctx = ctx + cg1 * yc
            ctx = ctx + cg2 * conv_ffn(modulate(rmsnorm(ctx, norm2_g[i]), csh2, csc2),
                                       ffn_w_up[i], ffn_conv_w[i], ffn_conv_b[i], ffn_w_down[i])
    return rmsnorm(x, final_g)
```

```cpp
#include <hip/hip_runtime.h>
#include <hip/hip_cooperative_groups.h>
#include <cstdio>
#include <cstdint>
namespace cg = cooperative_groups;

#define LAS __attribute__((address_space(3)))
typedef unsigned short bf16_t;
typedef short bf16x8 __attribute__((ext_vector_type(8)));
typedef short s16x4 __attribute__((ext_vector_type(4)));
typedef short v4i16_t __attribute__((ext_vector_type(4)));
typedef float f32x4 __attribute__((ext_vector_type(4)));
typedef float f32x8 __attribute__((ext_vector_type(8)));
typedef float f32x16 __attribute__((ext_vector_type(16)));
typedef unsigned u32x4 __attribute__((ext_vector_type(4)));
typedef unsigned u32x2 __attribute__((ext_vector_type(2)));

#ifndef SECMASK
#define SECMASK 0xFFFF
#endif
#define SEC(k) ((SECMASK >> (k)) & 1)
#ifndef MK_SPLIT
#define MK_SPLIT 0
#endif

constexpr int NB = 4, LSEQ = 4096, CTXL = 256, LT = LSEQ + CTXL, MQ = NB * LT, ML = NB * LSEQ, DM = 1024, NIN = 2560, FF = 2816, NUP = 5632;
constexpr int NCH = 2, CHROWS = ML / NCH;
constexpr float EPS = 1e-6f;

constexpr size_t WS_WIN = 0;
constexpr size_t WS_WO = WS_WIN + (size_t)NIN * DM * 2;
constexpr size_t WS_WF = WS_WO + (size_t)DM * DM * 2;
constexpr size_t WS_WUP = WS_WF + (size_t)DM * DM * 2;
constexpr size_t WS_WDN = WS_WUP + 2 * (size_t)NUP * DM * 2;
constexpr size_t WS_DFTC = WS_WDN + 2 * (size_t)DM * FF * 2;
constexpr size_t WS_F1 = WS_DFTC + 512 * 256 * 2;
constexpr size_t WS_F2 = WS_F1 + 128 * 128 * 2;
constexpr size_t WS_TW = WS_F2 + 64 * 128 * 2;
constexpr size_t WS_ROPE = WS_TW + 4096 * 8;
constexpr size_t WS_MOD = WS_ROPE + 64 * 32 * 8;
constexpr size_t WS_H = WS_MOD + 2 * 5 * 6144 * 4 + (512 << 10);
constexpr size_t WS_R0 = WS_H + (size_t)MQ * DM * 2 + (512 << 10);
constexpr size_t WS_QKV = WS_R0, WS_MIX = WS_QKV + (size_t)MQ * NIN * 2;
constexpr size_t WS_U = WS_R0, WS_ACT = WS_U + (size_t)CHROWS * NUP * 2;
constexpr size_t WS_Z = WS_R0, WS_A1 = WS_Z + (size_t)ML * 2048 * 2, WS_Y = WS_A1 + (size_t)ML * 2048 * 2;
constexpr size_t WS_END0 = WS_ACT + (size_t)ML * FF * 2, WS_END1 = WS_Y + (size_t)ML * DM * 2, WS_END2 = WS_MIX + (size_t)ML * DM * 2;
constexpr size_t WS_END = WS_END0 > WS_END1 ? (WS_END0 > WS_END2 ? WS_END0 : WS_END2) : (WS_END1 > WS_END2 ? WS_END1 : WS_END2);
static_assert(WS_END <= 268435456ull, "workspace map exceeds 256 MiB");
static_assert(WS_H % 256 == 0 && WS_R0 % 256 == 0 && WS_MOD % 256 == 0, "alignment");

constexpr int LDS_BYTES = 147456;

__device__ __forceinline__ unsigned f2bf(float f) { unsigned u = __float_as_uint(f); return (u + 0x7fffu + ((u >> 16) & 1u)) >> 16; }
__device__ __forceinline__ unsigned pk2(float lo, float hi) { return f2bf(lo) | (f2bf(hi) << 16); }
__device__ __forceinline__ float bf2f(unsigned v) { return __uint_as_float(v << 16); }
__device__ __forceinline__ unsigned cvt_pk_bf16(float lo, float hi) { unsigned r; asm volatile("v_cvt_pk_bf16_f32 %0, %1, %2" : "=v"(r) : "v"(lo), "v"(hi)); return r; }
__device__ __forceinline__ float wave_sum(float v) {
#pragma unroll
    for (int o = 1; o < 64; o <<= 1) v += __shfl_xor(v, o);
    return v;
}

namespace pg8 {
constexpr int BM = 256, BK = 64, HALF = 128, HTB = HALF * BK * 2, STAGE_BYTES = 8 * HTB, NXCD = 8, WGM = 8;
__host__ __device__ __forceinline__ int lds_byte(int r, int c) { const int st = (r >> 4) * 2 + (c >> 5), rr = r & 15, cc = c & 31, ob = rr * 64 + cc * 2; return st * 1024 + (ob ^ (((ob >> 9) & 1) << 5)); }
__host__ __device__ __forceinline__ void stage_rc(int b, int& R, int& C) { const int st = b / 1024, sb = b % 1024, swz = sb ^ (((sb >> 9) & 1) << 5); R = (st >> 1) * 16 + swz / 64; C = (st & 1) * 32 + (swz % 64) / 2; }
__host__ __device__ __forceinline__ int perm32(int rho) { const int n = rho >> 4, i = rho & 15; return 8 * (i >> 2) + 4 * n + (i & 3); }

struct Unit { int pm, pn; };
struct Gemm { const bf16_t* A; const bf16_t* Bt; int lda, ldb, K, gs; };

struct StaticOrder {
    int nM, nN, nwg, G, c;
    __host__ __device__ void init(int M, int N, int G_, int c_) { nM = M / BM; nN = N / BM; nwg = nM * nN; G = G_; c = c_; }
    __host__ __device__ bool next(int i, Unit& u) const {
        const long L = (long)i * G + c; if (L >= nwg) return false;
        int wgid = (int)L; { const int q = nwg / NXCD, r = nwg % NXCD, xcd = wgid % NXCD, off = wgid / NXCD; wgid = (xcd < r ? xcd * (q + 1) : r * (q + 1) + (xcd - r) * q) + off; }
        const int nig = WGM * nN, gid = wgid / nig, fm = gid * WGM, gsz = (nM - fm) < WGM ? (nM - fm) : WGM;
        u.pm = fm + ((wgid % nig) % gsz); u.pn = (wgid % nig) / gsz; return true;
    }
};

struct EpiStore {
    static constexpr bool PERM = true;
    bf16_t* O; int ldc;
    __device__ __forceinline__ void operator()(const f32x4 (&acc)[2][2][4][2], const Unit& u, int wr, int wc, int fr, int fq) const {
        const int row0 = u.pm * BM + wr * 64 + fr, col0 = u.pn * BM + wc * 32 + 8 * fq;
#pragma unroll
        for (int ai = 0; ai < 2; ++ai)
#pragma unroll
            for (int m = 0; m < 4; ++m) { bf16_t* rowp = O + (size_t)(row0 + ai * HALF + m * 16) * ldc + col0;
#pragma unroll
                for (int bj = 0; bj < 2; ++bj) { const f32x4 v0 = acc[ai][bj][m][0], v1 = acc[ai][bj][m][1];
                    u32x4 w; w.x = cvt_pk_bf16(v0[0], v0[1]); w.y = cvt_pk_bf16(v0[2], v0[3]); w.z = cvt_pk_bf16(v1[0], v1[1]); w.w = cvt_pk_bf16(v1[2], v1[3]);
                    *(u32x4*)(rowp + bj * HALF) = w; } }
    }
};
struct EpiResid {
    static constexpr bool PERM = true;
    const float* R; float* O; const float* gate;
    __device__ __forceinline__ void operator()(const f32x4 (&acc)[2][2][4][2], const Unit& u, int wr, int wc, int fr, int fq) const {
        const int row0 = u.pm * BM + wr * 64 + fr, col0 = u.pn * BM + wc * 32 + 8 * fq;
        const float* gp = gate + (size_t)((u.pm * BM) >> 12) * 6144 + col0;
        f32x4 gv[2][2];
#pragma unroll
        for (int bj = 0; bj < 2; ++bj)
#pragma unroll
            for (int n = 0; n < 2; ++n) gv[bj][n] = *(const f32x4*)(gp + bj * HALF + 4 * n);
#pragma unroll
        for (int ai = 0; ai < 2; ++ai)
#pragma unroll
            for (int m = 0; m < 4; ++m) { const size_t ro = (size_t)(row0 + ai * HALF + m * 16) * DM + col0;
#pragma unroll
                for (int bj = 0; bj < 2; ++bj)
#pragma unroll
                    for (int n = 0; n < 2; ++n) { const size_t idx = ro + bj * HALF + 4 * n;
                        const f32x4 r = *(const f32x4*)(R + idx);
                        *(f32x4*)(O + idx) = r + gv[bj][n] * acc[ai][bj][m][n]; } }
    }
};

template <class Epi>
__device__ __forceinline__ void gemm_phase(LAS unsigned char* lds, const Gemm g, const StaticOrder& S, const Epi& E) {
    const int tid = threadIdx.x, wid = __builtin_amdgcn_readfirstlane(tid >> 6), lane = tid & 63, wr = wid >> 2, wc = wid & 3, fr = lane & 15, fq = lane >> 4;
    const int K = g.K, nt = K / BK;
    unsigned voffA[2], voffB[2];
#pragma unroll
    for (int i = 0; i < 2; ++i) { int R, C; stage_rc(tid * 16 + i * 8192, R, C); const int Rb = Epi::PERM ? ((R & ~31) + perm32(R & 31)) : R;
        voffA[i] = (unsigned)(R * g.lda + C) * 2u; voffB[i] = (unsigned)(Rb * g.ldb + C) * 2u; }
    const size_t kstep = (size_t)(BK * 2);
    const size_t hstepA = (size_t)HALF * g.lda * 2, hstepB = (size_t)HALF * g.ldb * 2;
    const unsigned ldsw = (unsigned)wid * 1024u;
    const int aoff = lds_byte(wr * 64 + fr, fq * 8), boff = lds_byte(wc * 32 + fr, fq * 8);
    const int gmask = (1 << g.gs) - 1;
#define PG8_APTR(u) ((const char*)g.A + (size_t)(u).pm * 2 * hstepA + (size_t)((u).pn >> g.gs) * (size_t)K * 2)
#define PG8_BPTR(u) ((const char*)g.Bt + (size_t)((u).pn & gmask) * 2 * hstepB)
#define PG8_SA(b, h) (((b) * 2 + (h)) * HTB)
#define PG8_SB(b, h) ((4 + (b) * 2 + (h)) * HTB)
#define PG8_STAGE(bufoff, gbase, voff) do { _Pragma("unroll") for (int _i = 0; _i < 2; ++_i) \
        __builtin_amdgcn_global_load_lds((const unsigned*)((const char*)(gbase) + (voff)[_i]), (LAS unsigned*)(lds + (bufoff) + ldsw + _i * 8192), 16, 0, 0); } while (0)
#define PG8_LDA(dst, b, h) do { _Pragma("unroll") for (int m = 0; m < 4; ++m) _Pragma("unroll") for (int k = 0; k < 2; ++k) dst[m][k] = *(const LAS bf16x8*)(lds + PG8_SA(b, h) + aoff + m * 2048 + k * 1024); } while (0)
#define PG8_LDB(dst, b, h) do { _Pragma("unroll") for (int n = 0; n < 2; ++n) _Pragma("unroll") for (int k = 0; k < 2; ++k) dst[n][k] = *(const LAS bf16x8*)(lds + PG8_SB(b, h) + boff + n * 2048 + k * 1024); } while (0)
#define PG8_MMA(ai, bj, At, Bt) do { __builtin_amdgcn_s_setprio(1); _Pragma("unroll") for (int m = 0; m < 4; ++m) _Pragma("unroll") for (int n = 0; n < 2; ++n) _Pragma("unroll") for (int k = 0; k < 2; ++k) \
        acc[ai][bj][m][n] = __builtin_amdgcn_mfma_f32_16x16x32_bf16(Bt[n][k], At[m][k], acc[ai][bj][m][n], 0, 0, 0); __builtin_amdgcn_s_setprio(0); } while (0)
#define PG8_WAIT_V(n) asm volatile("s_waitcnt vmcnt(" #n ")" ::: "memory")
#define PG8_WAIT_L(n) asm volatile("s_waitcnt lgkmcnt(" #n ")" ::: "memory")
#define PG8_BAR __builtin_amdgcn_s_barrier()
#define PG8_SCHED __builtin_amdgcn_sched_barrier(0)
    Unit cur, nxt; int ui = 0;
    if (!S.next(0, cur)) return;
    f32x4 acc[2][2][4][2];
#pragma unroll
    for (int a = 0; a < 2; ++a)
#pragma unroll
        for (int b = 0; b < 2; ++b)
#pragma unroll
            for (int m = 0; m < 4; ++m)
#pragma unroll
                for (int n = 0; n < 2; ++n) acc[a][b][m][n] = (f32x4){0.f, 0.f, 0.f, 0.f};
    bf16x8 At[4][2], B0[2][2], B1[2][2];
    const char* cA = PG8_APTR(cur); const char* cB = PG8_BPTR(cur);
    PG8_STAGE(PG8_SB(0, 0), cB, voffB); PG8_STAGE(PG8_SB(0, 1), cB + hstepB, voffB); PG8_STAGE(PG8_SA(0, 0), cA, voffA); PG8_STAGE(PG8_SA(0, 1), cA + hstepA, voffA);
    if (wr == 1) PG8_BAR;
    PG8_WAIT_V(2); PG8_BAR;
    PG8_STAGE(PG8_SB(1, 0), cB + kstep, voffB); PG8_STAGE(PG8_SA(1, 0), cA + kstep, voffA); PG8_STAGE(PG8_SB(1, 1), cB + hstepB + kstep, voffB);
    PG8_WAIT_V(6); PG8_BAR;
    for (;;) {
        const bool has_next = S.next(ui + 1, nxt);
        const char* nA = has_next ? PG8_APTR(nxt) : cA; const char* nB = has_next ? PG8_BPTR(nxt) : cB;
        for (int t = 0; t < nt; t += 2) {
            const bool last = (t == nt - 2);
            const char* a1 = cA + (size_t)(t + 1) * kstep;
            const char* a2 = last ? nA : cA + (size_t)(t + 2) * kstep; const char* b2 = last ? nB : cB + (size_t)(t + 2) * kstep;
            const char* a3 = a2 + kstep; const char* b3 = b2 + kstep;
            PG8_LDB(B0, 0, 0); PG8_LDB(B1, 0, 1); PG8_SCHED; PG8_LDA(At, 0, 0); PG8_STAGE(PG8_SA(1, 1), a1 + hstepA, voffA);
            PG8_WAIT_V(8); PG8_WAIT_L(0); PG8_BAR; PG8_MMA(0, 0, At, B0); PG8_MMA(0, 1, At, B1); PG8_BAR; PG8_SCHED;
            PG8_LDA(At, 0, 1); PG8_STAGE(PG8_SB(0, 0), b2, voffB); PG8_STAGE(PG8_SB(0, 1), b2 + hstepB, voffB); PG8_STAGE(PG8_SA(0, 0), a2, voffA);
            PG8_WAIT_V(8); PG8_WAIT_L(0); PG8_BAR; PG8_MMA(1, 0, At, B0); PG8_MMA(1, 1, At, B1); PG8_BAR; PG8_SCHED;
            PG8_LDB(B0, 1, 0); PG8_LDB(B1, 1, 1); PG8_SCHED; PG8_LDA(At, 1, 0); PG8_STAGE(PG8_SA(0, 1), a2 + hstepA, voffA);
            PG8_WAIT_V(8); PG8_WAIT_L(0); PG8_BAR; PG8_MMA(0, 0, At, B0); PG8_MMA(0, 1, At, B1); PG8_BAR; PG8_SCHED;
            PG8_LDA(At, 1, 1); PG8_STAGE(PG8_SB(1, 0), b3, voffB); PG8_STAGE(PG8_SB(1, 1), b3 + hstepB, voffB); PG8_STAGE(PG8_SA(1, 0), a3, voffA);
            PG8_WAIT_V(8); PG8_WAIT_L(0); PG8_BAR; PG8_MMA(1, 0, At, B0); PG8_MMA(1, 1, At, B1); PG8_BAR; PG8_SCHED;
        }
        if (wr == 0) PG8_BAR;
        E(acc, cur, wr, wc, fr, fq);
        if (!has_next) break;
#pragma unroll
        for (int a = 0; a < 2; ++a)
#pragma unroll
            for (int b = 0; b < 2; ++b)
#pragma unroll
                for (int m = 0; m < 4; ++m)
#pragma unroll
                    for (int n = 0; n < 2; ++n) acc[a][b][m][n] = (f32x4){0.f, 0.f, 0.f, 0.f};
        cur = nxt; cA = nA; cB = nB; ++ui;
        if (wr == 1) PG8_BAR;
    }
    PG8_WAIT_V(0);
    PG8_BAR;
#undef PG8_APTR
#undef PG8_BPTR
#undef PG8_SA
#undef PG8_SB
#undef PG8_STAGE
#undef PG8_LDA
#undef PG8_LDB
#undef PG8_MMA
#undef PG8_WAIT_V
#undef PG8_WAIT_L
#undef PG8_BAR
#undef PG8_SCHED
}
}

namespace att {
constexpr int D = 128, NW = 8, QBLK = 32, KVBLK = 64;
constexpr float SCALE = 0.088388347648318440f;
constexpr float THR = 8.f;
constexpr int LDQ = NIN, LDK = NIN, LDO = DM;
constexpr size_t SHM_V = KVBLK * D * 2, SHM_K = KVBLK * D * 2, SHM_ATTN = 2 * SHM_V + 2 * SHM_K + NW * 64 * 4;
#define KSWZ(row, colB) ((row) * 256 + ((colB) ^ (((row) & 7) << 4)))
#define SBAR() __builtin_amdgcn_sched_barrier(0)
__device__ __forceinline__ int crow(int r, int hi) { return (r & 3) + 8 * (r >> 2) + 4 * hi; }
__device__ __forceinline__ unsigned cvtpk(float lo, float hi) { unsigned r; asm volatile("v_cvt_pk_bf16_f32 %0, %1, %2" : "=v"(r) : "v"(lo), "v"(hi)); return r; }

__device__ __forceinline__ void partialSM(f32x16& p0, f32x16& p1, float& m_reg, float& mn, float& alpha) {
  constexpr float C = SCALE * 1.4426950408889634f;
  float pmax = p0[0];
#pragma unroll
  for (int r = 1; r < 16; ++r) pmax = fmaxf(pmax, p0[r]);
#pragma unroll
  for (int r = 0; r < 16; ++r) pmax = fmaxf(pmax, p1[r]);
  { auto rr = __builtin_amdgcn_permlane32_swap(__float_as_uint(pmax), __float_as_uint(pmax), false, false);
    pmax = fmaxf(__uint_as_float(rr[0]), __uint_as_float(rr[1])); }
  if (__builtin_expect(__all(pmax - m_reg <= THR / SCALE), 1)) { mn = m_reg; alpha = 1.f; }
  else { mn = fmaxf(m_reg, pmax); alpha = __builtin_amdgcn_exp2f((m_reg - mn) * C); m_reg = mn; }
  float mnC = -mn * C;
#pragma unroll
  for (int r = 0; r < 16; ++r) p0[r] = fmaf(p0[r], C, mnC);
#pragma unroll
  for (int r = 0; r < 16; ++r) p1[r] = fmaf(p1[r], C, mnC);
#pragma unroll
  for (int r = 0; r < 16; ++r) p0[r] = __builtin_amdgcn_exp2f(p0[r]);
}
__device__ __forceinline__ void finishSM(f32x16& p0, f32x16& p1, float alpha, float& l_reg, bf16x8& pa0, bf16x8& pa1, bf16x8& pa2, bf16x8& pa3) {
#pragma unroll
  for (int r = 0; r < 16; ++r) p1[r] = __builtin_amdgcn_exp2f(p1[r]);
  float ps = 0;
#pragma unroll
  for (int r = 0; r < 16; ++r) ps += p0[r];
#pragma unroll
  for (int r = 0; r < 16; ++r) ps += p1[r];
  { auto rr = __builtin_amdgcn_permlane32_swap(__float_as_uint(ps), __float_as_uint(ps), false, false);
    ps = __uint_as_float(rr[0]) + __uint_as_float(rr[1]); }
  l_reg = l_reg * alpha + ps;
#define PK4(P, BASE, OUT) do { unsigned a0 = cvtpk(P[BASE + 0], P[BASE + 1]), a1 = cvtpk(P[BASE + 2], P[BASE + 3]);   \
    unsigned b0 = cvtpk(P[BASE + 4], P[BASE + 5]), b1 = cvtpk(P[BASE + 6], P[BASE + 7]);                              \
    auto r0 = __builtin_amdgcn_permlane32_swap(a0, b0, false, false); auto r1 = __builtin_amdgcn_permlane32_swap(a1, b1, false, false); \
    u32x4 w = {r0[0], r1[0], r0[1], r1[1]}; OUT = *reinterpret_cast<bf16x8*>(&w); } while (0)
  PK4(p0, 0, pa0); PK4(p0, 8, pa1); PK4(p1, 0, pa2); PK4(p1, 8, pa3);
#undef PK4
}
__device__ __forceinline__ void qkt(f32x16& p0, f32x16& p1, const bf16_t* Ks, const bf16x8* qr, int r32, int hi) {
  p0 = f32x16{}; p1 = f32x16{};
#pragma unroll
  for (int d0 = 0; d0 < 8; ++d0) { int cb = (d0 * 16 + hi * 8) * 2;
    bf16x8 b0 = *reinterpret_cast<const bf16x8*>((const char*)Ks + KSWZ(r32, cb));
    bf16x8 b1 = *reinterpret_cast<const bf16x8*>((const char*)Ks + KSWZ(32 + r32, cb));
    p0 = __builtin_amdgcn_mfma_f32_32x32x16_bf16(b0, qr[d0], p0, 0, 0, 0);
    p1 = __builtin_amdgcn_mfma_f32_32x32x16_bf16(b1, qr[d0], p1, 0, 0, 0); }
}
__device__ __forceinline__ int v_st(int k, int c) { const int kk = (k & ~0xC) | ((k & 4) << 1) | ((k & 8) >> 1); return ((kk >> 3) * 4 + (c >> 5)) * 512 + ((kk & 7) * 32 + (c & 31)) * 2; }
__device__ __forceinline__ int v_rd_base(int lane) { return ((lane & 3) << 3) | (((lane >> 2) & 3) << 6) | (((lane >> 4) & 1) << 5) | (((lane >> 5) & 1) << 8); }
constexpr int v_rd_off(int d0, int ks, int half) { return d0 * 512 + ks * 4096 + half * 2048; }
template <int OFF> __device__ __forceinline__ s16x4 tr_read(int vb) {
  s16x4 r; asm volatile("ds_read_b64_tr_b16 %0, %1 offset:%2" : "=&v"(r) : "v"(vb), "i"(OFF) : "memory"); return r;
}
template <int D0> __device__ __forceinline__ void pv_one(f32x16& od, int vb, bf16x8 pa0, bf16x8 pa1, bf16x8 pa2, bf16x8 pa3) {
  const s16x4 l0 = tr_read<v_rd_off(D0, 0, 0)>(vb), h0 = tr_read<v_rd_off(D0, 0, 1)>(vb), l1 = tr_read<v_rd_off(D0, 1, 0)>(vb), h1 = tr_read<v_rd_off(D0, 1, 1)>(vb);
  const s16x4 l2 = tr_read<v_rd_off(D0, 2, 0)>(vb), h2 = tr_read<v_rd_off(D0, 2, 1)>(vb), l3 = tr_read<v_rd_off(D0, 3, 0)>(vb), h3 = tr_read<v_rd_off(D0, 3, 1)>(vb);
  asm volatile("s_waitcnt lgkmcnt(0)" ::: "memory"); SBAR();
#define PK(L, H) (bf16x8){L[0], L[1], L[2], L[3], H[0], H[1], H[2], H[3]}
  od = __builtin_amdgcn_mfma_f32_32x32x16_bf16(pa0, PK(l0, h0), od, 0, 0, 0);
  od = __builtin_amdgcn_mfma_f32_32x32x16_bf16(pa1, PK(l1, h1), od, 0, 0, 0);
  od = __builtin_amdgcn_mfma_f32_32x32x16_bf16(pa2, PK(l2, h2), od, 0, 0, 0);
  od = __builtin_amdgcn_mfma_f32_32x32x16_bf16(pa3, PK(l3, h3), od, 0, 0, 0);
#undef PK
}
__device__ __forceinline__ void pv_d0(f32x16* o, int vb, bf16x8 pa0, bf16x8 pa1, bf16x8 pa2, bf16x8 pa3) {
  pv_one<0>(o[0], vb, pa0, pa1, pa2, pa3); pv_one<1>(o[1], vb, pa0, pa1, pa2, pa3); pv_one<2>(o[2], vb, pa0, pa1, pa2, pa3); pv_one<3>(o[3], vb, pa0, pa1, pa2, pa3);
}

__device__ __forceinline__ void attn_dense_body(const bf16_t* __restrict__ Qb, const bf16_t* __restrict__ Kh, const bf16_t* __restrict__ Vh,
                                                bf16_t* __restrict__ Ob, int seq, char* lds) {
  const int tid = threadIdx.x, wid = tid >> 6, lane = tid & 63, r32 = lane & 31, hi = lane >> 5;
  bf16_t* V_lds = (bf16_t*)lds; bf16_t* K_lds = (bf16_t*)(lds + 2 * SHM_V);
  float* ws = (float*)(lds + 2 * SHM_V + 2 * SHM_K) + wid * 64; float* li_l = ws; float* al_l = ws + 32;
  float m_reg = -1e30f, l_reg = 0; f32x16 o[4] = {}; bf16x8 qr[8];
  const bf16_t* Qw = Qb + (long)(wid * QBLK + r32) * LDQ + hi * 8;
#pragma unroll
  for (int d0 = 0; d0 < 8; ++d0) qr[d0] = *reinterpret_cast<const bf16x8*>(Qw + d0 * 16);
  const int sr = tid >> 4, sc = (tid & 15) * 8, vst0 = v_st(sr, sc), vst1 = v_st(32 + sr, sc);
  const int vb0 = (int)(uintptr_t)V_lds + v_rd_base(lane);
  struct { bf16x8 vs0, vs1, ks0, ks1; } sr_[2];
#define SLOAD(i, k0) do { sr_[i].vs0 = *reinterpret_cast<const bf16x8*>(&Vh[(long)((k0) + sr) * LDK + sc]); sr_[i].vs1 = *reinterpret_cast<const bf16x8*>(&Vh[(long)((k0) + 32 + sr) * LDK + sc]); \
    sr_[i].ks0 = *reinterpret_cast<const bf16x8*>(&Kh[(long)((k0) + sr) * LDK + sc]); sr_[i].ks1 = *reinterpret_cast<const bf16x8*>(&Kh[(long)((k0) + 32 + sr) * LDK + sc]); } while (0)
#define SWRITE(b, i) do { *(bf16x8*)((char*)V_lds + (b) * SHM_V + vst0) = sr_[i].vs0;          \
    *(bf16x8*)((char*)V_lds + (b) * SHM_V + vst1) = sr_[i].vs1; int kc = sc * 2;               \
    *(bf16x8*)((char*)K_lds + (b) * SHM_K + KSWZ(sr, kc)) = sr_[i].ks0;                       \
    *(bf16x8*)((char*)K_lds + (b) * SHM_K + KSWZ(32 + sr, kc)) = sr_[i].ks1; } while (0)
#define SWAIT() asm volatile("s_waitcnt vmcnt(4)" ::: "memory")
#define RESC(a) do { if (__any((a) < 1.f)) { if (hi == 0) al_l[r32] = (a); asm volatile("s_waitcnt lgkmcnt(0)" ::: "memory"); \
    _Pragma("unroll") for (int d = 0; d < 4; ++d) _Pragma("unroll") for (int r = 0; r < 16; ++r) o[d][r] *= al_l[crow(r, hi)]; } } while (0)
  f32x16 pA0, pA1, pB0, pB1; float mnA, mnB, alA, alB; bf16x8 pa0, pa1, pa2, pa3; const int NT = seq / KVBLK;
  constexpr int SE = 0, SO = 1;
  SLOAD(SE, 0); asm volatile("s_waitcnt vmcnt(0)" ::: "memory"); SWRITE(0, SE); __syncthreads();
  qkt(pA0, pA1, K_lds, qr, r32, hi); partialSM(pA0, pA1, m_reg, mnA, alA);
  SLOAD(SO, KVBLK); if (2 < NT) SLOAD(SE, 2 * KVBLK);
  SWAIT(); SWRITE(1, SO); __syncthreads();
  for (int j = 1; j + 1 < NT; j += 2) {
    SBAR(); qkt(pB0, pB1, (bf16_t*)((char*)K_lds + SHM_K), qr, r32, hi);
    finishSM(pA0, pA1, alA, l_reg, pa0, pa1, pa2, pa3); SBAR();
    SLOAD(SO, (j + 2) * KVBLK); SBAR();
    pv_d0(o, vb0, pa0, pa1, pa2, pa3); partialSM(pB0, pB1, m_reg, mnB, alB);
    __syncthreads(); SWAIT(); SWRITE(0, SE);
    RESC(alB); __syncthreads();
    SBAR(); qkt(pA0, pA1, K_lds, qr, r32, hi);
    finishSM(pB0, pB1, alB, l_reg, pa0, pa1, pa2, pa3); SBAR();
    if (j + 3 < NT) SLOAD(SE, (j + 3) * KVBLK); SBAR();
    pv_d0(o, vb0 + (int)SHM_V, pa0, pa1, pa2, pa3); partialSM(pA0, pA1, m_reg, mnA, alA);
    __syncthreads(); SWAIT(); SWRITE(1, SO);
    RESC(alA); __syncthreads();
  }
  SBAR(); qkt(pB0, pB1, (bf16_t*)((char*)K_lds + SHM_K), qr, r32, hi);
  finishSM(pA0, pA1, alA, l_reg, pa0, pa1, pa2, pa3); SBAR();
  pv_d0(o, vb0, pa0, pa1, pa2, pa3); partialSM(pB0, pB1, m_reg, mnB, alB);
  __syncthreads(); RESC(alB);
  finishSM(pB0, pB1, alB, l_reg, pa0, pa1, pa2, pa3); SBAR();
  pv_d0(o, vb0 + (int)SHM_V, pa0, pa1, pa2, pa3);
  if (hi == 0) li_l[r32] = l_reg; asm volatile("s_waitcnt lgkmcnt(0)" ::: "memory");
  float rli[16];
#pragma unroll
  for (int r = 0; r < 16; ++r) rli[r] = __builtin_amdgcn_rcpf(li_l[crow(r, hi)]);
  bf16_t* Ow = Ob + (long)(wid * QBLK) * LDO;
#pragma unroll
  for (int r = 0; r < 16; ++r) { int orow = crow(r, hi);
#pragma unroll
    for (int d0 = 0; d0 < 4; ++d0) Ow[(long)orow * LDO + d0 * 32 + r32] = (bf16_t)f2bf(o[d0][r] * rli[r]); }
  __syncthreads();
#undef SLOAD
#undef SWRITE
#undef SWAIT
#undef RESC
}
}

struct Args { const float* in[19]; float* out; unsigned char* ws; int ph_lo, ph_hi; };
enum { I_X = 0, I_C, I_CTX, I_CCTX, I_MODW, I_MODB, I_N1G, I_N2G, I_WIN, I_WOUT, I_QG, I_KG, I_RPB, I_FW, I_WUP, I_CW, I_CB, I_WDN, I_FG };

__device__ __forceinline__ s16x4 vtr(const LAS unsigned char* p) { return __builtin_bit_cast(s16x4, __builtin_amdgcn_ds_read_tr16_b64_v4i16((LAS v4i16_t*)p)); }

__device__ __forceinline__ int up_perm(int n) { return n < FF ? ((n >> 7) * 256 + (n & 127)) : ((((n - FF) >> 7) * 256) + 128 + ((n - FF) & 127)); }

__device__ __forceinline__ void transpose_tile(const float* __restrict__ W, int N, bf16_t* __restrict__ WT, int ldt, int tk, int tn, bool perm, LAS float* scr) {
    const int tid = threadIdx.x;
#pragma unroll
    for (int i = 0; i < 8; ++i) { const int kk = (tid >> 6) + 8 * i, nn = tid & 63; scr[kk * 65 + nn] = W[(size_t)(tk * 64 + kk) * N + tn * 64 + nn]; }
    __syncthreads();
    { const int nn = tid >> 3, kc = tid & 7; float v[8];
#pragma unroll
      for (int e = 0; e < 8; ++e) v[e] = scr[(kc * 8 + e) * 65 + nn];
      const int n = tn * 64 + nn, nrow = perm ? up_perm(n) : n;
      u32x4 w; w.x = pk2(v[0], v[1]); w.y = pk2(v[2], v[3]); w.z = pk2(v[4], v[5]); w.w = pk2(v[6], v[7]);
      *(u32x4*)(WT + (size_t)nrow * ldt + tk * 64 + kc * 8) = w; }
    __syncthreads();
}

__device__ __forceinline__ void adaln_item(const Args& a, int item, float* MOD, LAS float* sv, LAS float* red) {
    const int tid = threadIdx.x, l = item / 96, j = item % 96;
    const float* c = a.in[I_C]; const float* cc = a.in[I_CCTX];
    for (int idx = tid; idx < 5 * 1024; idx += 512) { const int r = idx >> 10, k = idx & 1023; const float v = r < 4 ? c[r * 1024 + k] : cc[k]; sv[idx] = v / (1.f + __expf(-v)); }
    __syncthreads();
    const int col = tid & 63, kg = tid >> 6;
    const float* w = a.in[I_MODW] + (size_t)l * 1024 * 6144 + j * 64 + col;
    float acc[5] = {0.f, 0.f, 0.f, 0.f, 0.f};
    for (int k = kg * 128; k < kg * 128 + 128; ++k) { const float wv = w[(size_t)k * 6144];
#pragma unroll
        for (int r = 0; r < 5; ++r) acc[r] += sv[r * 1024 + k] * wv; }
#pragma unroll
    for (int r = 0; r < 5; ++r) red[(kg * 5 + r) * 64 + col] = acc[r];
    __syncthreads();
    if (tid < 320) { const int r = tid >> 6, cl = tid & 63; float s = 0.f;
#pragma unroll
        for (int g = 0; g < 8; ++g) s += red[(g * 5 + r) * 64 + cl];
        MOD[(size_t)(l * 5 + r) * 6144 + j * 64 + cl] = s + a.in[I_MODB][l * 6144 + j * 64 + cl]; }
    __syncthreads();
}

__device__ __forceinline__ void p0_prologue(const Args& a, LAS unsigned char* lds, int G, int bx) {
    unsigned char* ws = a.ws;
    const int tid = threadIdx.x;
    {
        const long gt = (long)bx * 512 + tid, GT = (long)G * 512;
        bf16_t* dftc = (bf16_t*)(ws + WS_DFTC);
        for (long i = gt; i < 512 * 256; i += GT) { const int row = (int)(i >> 8), n = (int)(i & 255), ri = row >> 8, m = row & 255; float s, c; sincospif((float)((m * n) & 255) * (1.f / 128.f), &s, &c); dftc[i] = (bf16_t)f2bf(ri ? -s : c); }
        bf16_t* f1 = (bf16_t*)(ws + WS_F1);
        for (long i = gt; i < 128 * 128; i += GT) { const int row = (int)(i >> 7), col = (int)(i & 127), ro = row >> 6, k1 = row & 63, ri = col >> 6, t1 = col & 63; float s, c; sincospif((float)((k1 * t1) & 63) * (1.f / 32.f), &s, &c);
            const float v = (ro == 0) ? (ri == 0 ? c : s) : (ri == 0 ? -s : c); f1[i] = (bf16_t)f2bf(v); }
        bf16_t* f2 = (bf16_t*)(ws + WS_F2);
        for (long i = gt; i < 64 * 128; i += GT) { const int k2 = (int)(i >> 7), col = (int)(i & 127), ri = col >> 6, t2 = col & 63; float s, c; sincospif((float)((k2 * t2) & 63) * (1.f / 32.f), &s, &c); f2[i] = (bf16_t)f2bf(ri == 0 ? c : s); }
        float2* tw = (float2*)(ws + WS_TW);
        for (long i = gt; i < 4096; i += GT) { float s, c; sincospif((float)i * (1.f / 2048.f), &s, &c); tw[i] = make_float2(c, s); }
        float2* rope = (float2*)(ws + WS_ROPE);
        for (long i = gt; i < 64 * 32; i += GT) { const int pos = (int)(i >> 5), j = (int)(i & 31); const float fr = powf(10000.f, -(float)j / 32.f); const float ang = (float)pos * fr; rope[i] = make_float2(cosf(ang), sinf(ang)); }
    }
    LAS float* scr = (LAS float*)lds;
    for (int it = bx; it < 192; it += G) adaln_item(a, it, (float*)(ws + WS_MOD), scr, scr + 5 * 1024);
    for (int t = bx; t < 5376; t += G) {
        if (t < 640) transpose_tile(a.in[I_WIN], NIN, (bf16_t*)(ws + WS_WIN), DM, t / 40, t % 40, false, scr);
        else if (t < 896) { const int u = t - 640; transpose_tile(a.in[I_WOUT], DM, (bf16_t*)(ws + WS_WO), DM, u / 16, u % 16, false, scr); }
        else if (t < 1152) { const int u = t - 896; transpose_tile(a.in[I_FW], DM, (bf16_t*)(ws + WS_WF), DM, u / 16, u % 16, false, scr); }
        else if (t < 3968) { const int u = t - 1152, l = u / 1408, v = u % 1408; transpose_tile(a.in[I_WUP] + (size_t)l * DM * NUP, NUP, (bf16_t*)(ws + WS_WUP) + (size_t)l * NUP * DM, DM, v / 88, v % 88, true, scr); }
        else { const int u = t - 3968, l = u / 704, v = u % 704; transpose_tile(a.in[I_WDN] + (size_t)l * FF * DM, DM, (bf16_t*)(ws + WS_WDN) + (size_t)l * DM * FF, FF, v / 16, v % 16, false, scr); }
    }
}

__device__ __forceinline__ void norm_mod_phase(const float* __restrict__ xl, const float* __restrict__ xc, bool with_ctx, const float* __restrict__ gain,
                                               const float* __restrict__ MODl, int chunk, bf16_t* __restrict__ out, int G, int bx) {
    const int wid = threadIdx.x >> 6, lane = threadIdx.x & 63;
    const int nrows = with_ctx ? MQ : ML;
    for (int row = bx * 8 + wid; row < nrows; row += G * 8) {
        int b, t; if (with_ctx) { b = row / LT; t = row - b * LT; } else { b = row >> 12; t = row & 4095; }
        const float* src = (t < LSEQ) ? xl + ((size_t)b * LSEQ + t) * DM : xc + ((size_t)b * CTXL + (t - LSEQ)) * DM;
        const float* mrow = MODl + (size_t)((t < LSEQ) ? b : 4) * 6144 + chunk * 1024;
        f32x4 v[4]; float ss = 0.f;
#pragma unroll
        for (int j = 0; j < 4; ++j) { v[j] = *(const f32x4*)(src + j * 256 + lane * 4); ss += v[j][0] * v[j][0] + v[j][1] * v[j][1] + v[j][2] * v[j][2] + v[j][3] * v[j][3]; }
        ss = wave_sum(ss);
        const float rstd = rsqrtf(ss * (1.f / 1024.f) + EPS);
#pragma unroll
        for (int j = 0; j < 4; ++j) { const int c = j * 256 + lane * 4;
            const f32x4 g = *(const f32x4*)(gain + c), sh = *(const f32x4*)(mrow + c), sc = *(const f32x4*)(mrow + 1024 + c);
            const f32x4 y = (v[j] * rstd * g) * (sc + 1.f) + sh;
            u32x2 w; w.x = pk2(y[0], y[1]); w.y = pk2(y[2], y[3]);
            *(u32x2*)(out + (size_t)row * DM + c) = w; }
    }
}

__device__ __forceinline__ void final_norm_phase(float* __restrict__ x, const float* __restrict__ gain, int G, int bx) {
    const int wid = threadIdx.x >> 6, lane = threadIdx.x & 63;
    for (int row = bx * 8 + wid; row < ML; row += G * 8) {
        float* src = x + (size_t)row * DM;
        f32x4 v[4]; float ss = 0.f;
#pragma unroll
        for (int j = 0; j < 4; ++j) { v[j] = *(const f32x4*)(src + j * 256 + lane * 4); ss += v[j][0] * v[j][0] + v[j][1] * v[j][1] + v[j][2] * v[j][2] + v[j][3] * v[j][3]; }
        ss = wave_sum(ss);
        const float rstd = rsqrtf(ss * (1.f / 1024.f) + EPS);
#pragma unroll
        for (int j = 0; j < 4; ++j) { const int c = j * 256 + lane * 4; const f32x4 g = *(const f32x4*)(gain + c); *(f32x4*)(src + c) = v[j] * rstd * g; }
    }
}

__device__ __forceinline__ void qknorm_phase(bf16_t* __restrict__ QKV, const float* __restrict__ qg, const float* __restrict__ kg, const float2* __restrict__ rope, int G, int bx) {
    const int wid = threadIdx.x >> 6, lane = threadIdx.x & 63;
    const long total = (long)MQ * 6;
    for (long wi = (long)bx * 8 + wid; wi < total; wi += (long)G * 8) {
        const int row = (int)(wi / 6), slot = (int)(wi - (long)row * 6);
        const int b = row / LT, t = row - b * LT;
        const bool isctx = t >= LSEQ;
        if (isctx && slot < 4) continue;
        const int col0 = slot < 4 ? slot * 128 : 1024 + (slot - 4) * 128;
        const float* gw = slot < 4 ? qg : kg;
        unsigned* p = (unsigned*)(QKV + (size_t)row * NIN + col0) + lane;
        const unsigned raw = *p;
        float x0 = bf2f(raw & 0xffffu), x1 = bf2f(raw >> 16);
        const float ss = wave_sum(x0 * x0 + x1 * x1);
        const float rstd = rsqrtf(ss * (1.f / 128.f) + EPS);
        x0 = x0 * rstd * gw[2 * lane]; x1 = x1 * rstd * gw[2 * lane + 1];
        if (!isctx) {
            const int pos = lane < 32 ? (t >> 6) : (t & 63);
            const float2 cs = rope[pos * 32 + (lane & 31)];
            const float y0 = x0 * cs.x - x1 * cs.y, y1 = x0 * cs.y + x1 * cs.x; x0 = y0; x1 = y1;
        }
        *p = pk2(x0, x1);
    }
}

constexpr int NA_VPITCH = 144, NA_VBUF = 32 * NA_VPITCH;
constexpr int NA_MOFF = 8 * NA_VBUF;
__device__ __forceinline__ void na_item(const bf16_t* __restrict__ QKV, const float* __restrict__ rpb, bf16_t* __restrict__ MIX, int b, int hb, int r, LAS unsigned char* lds) {
    const int tid = threadIdx.x, wid = __builtin_amdgcn_readfirstlane(tid >> 6), lane = tid & 63, n = lane & 15, kq = lane >> 4;
    const int qg = wid & 3, kh = wid >> 2;
    const int c0 = qg * 16, kc0 = (qg == 0) ? 0 : (qg == 1) ? 8 : (qg == 2) ? 24 : 32;
    const int r0 = min(max(r - 4, 0), 56);
    const bf16_t* base = QKV + (size_t)b * LT * NIN;
    const bf16_t* qp = base + (size_t)(r * 64 + c0 + n) * NIN + 512 + hb * 64 + 8 * kq;
    const bf16x8 qf0 = *(const bf16x8*)qp, qf1 = *(const bf16x8*)(qp + 32);
    f32x4 s[16];
#pragma unroll
    for (int kb = 0; kb < 16; ++kb) {
        const int tok = kh == 0 ? ((r0 + (kb >> 1)) * 64 + kc0 + 16 * (kb & 1) + n) : (LSEQ + 16 * kb + n);
        const bf16_t* kp = base + (size_t)tok * NIN + 1536 + hb * 64 + 8 * kq;
        const bf16x8 a0 = *(const bf16x8*)kp, a1 = *(const bf16x8*)(kp + 32);
        f32x4 acc = {0.f, 0.f, 0.f, 0.f};
        acc = __builtin_amdgcn_mfma_f32_16x16x32_bf16(a0, qf0, acc, 0, 0, 0);
        acc = __builtin_amdgcn_mfma_f32_16x16x32_bf16(a1, qf1, acc, 0, 0, 0);
        s[kb] = acc;
    }
    float mx = -1e30f;
    if (kh == 0) {
        const int c = c0 + n, cs = min(max(c - 8, 0), 48);
        const float* rp = rpb + hb * 15 * 31;
#pragma unroll
        for (int kb = 0; kb < 16; ++kb) { const int i = kb >> 1, ro = r0 + i - r + 7;
#pragma unroll
            for (int j = 0; j < 4; ++j) { const int kc = kc0 + 16 * (kb & 1) + 4 * kq + j; const bool valid = (kc >= cs) && (kc < cs + 16);
                const int co = min(max(kc - c + 15, 0), 30);
                const float bias = rp[ro * 31 + co];
                const float v = valid ? s[kb][j] * 0.125f + bias : -1e30f; s[kb][j] = v; mx = fmaxf(mx, v); } }
    } else {
#pragma unroll
        for (int kb = 0; kb < 16; ++kb)
#pragma unroll
            for (int j = 0; j < 4; ++j) { const float v = s[kb][j] * 0.125f; s[kb][j] = v; mx = fmaxf(mx, v); }
    }
    mx = fmaxf(mx, __shfl_xor(mx, 16)); mx = fmaxf(mx, __shfl_xor(mx, 32));
    float lsum = 0.f;
#pragma unroll
    for (int kb = 0; kb < 16; ++kb)
#pragma unroll
        for (int j = 0; j < 4; ++j) { const float p = __builtin_amdgcn_exp2f((s[kb][j] - mx) * 1.4426950408889634f); s[kb][j] = p; lsum += p; }
    lsum += __shfl_xor(lsum, 16); lsum += __shfl_xor(lsum, 32);
    f32x4 o[4];
#pragma unroll
    for (int d = 0; d < 4; ++d) o[d] = (f32x4){0.f, 0.f, 0.f, 0.f};
    LAS unsigned char* vbuf = lds + wid * NA_VBUF;
    const int vrow = lane >> 1, vhalf = lane & 1;
    const LAS unsigned char* trp = vbuf + (4 * kq + (n >> 2)) * NA_VPITCH + (n & 3) * 8;
#pragma unroll
    for (int t = 0; t < 8; ++t) {
        const int tok0 = kh == 0 ? ((r0 + t) * 64 + kc0) : (LSEQ + 32 * t);
        const bf16_t* vp = base + (size_t)(tok0 + vrow) * NIN + 2048 + hb * 64 + vhalf * 32;
        const u32x4 v0 = *(const u32x4*)vp, v1 = *(const u32x4*)(vp + 8), v2 = *(const u32x4*)(vp + 16), v3 = *(const u32x4*)(vp + 24);
        LAS u32x4* wp = (LAS u32x4*)(vbuf + vrow * NA_VPITCH + vhalf * 64);
        wp[0] = v0; wp[1] = v1; wp[2] = v2; wp[3] = v3;
        u32x4 bw; bw.x = cvt_pk_bf16(s[2 * t][0], s[2 * t][1]); bw.y = cvt_pk_bf16(s[2 * t][2], s[2 * t][3]); bw.z = cvt_pk_bf16(s[2 * t + 1][0], s[2 * t + 1][1]); bw.w = cvt_pk_bf16(s[2 * t + 1][2], s[2 * t + 1][3]);
        const bf16x8 bfr = __builtin_bit_cast(bf16x8, bw);
#pragma unroll
        for (int d = 0; d < 4; ++d) {
            const s16x4 lo = vtr(trp + d * 32), hi = vtr(trp + 16 * NA_VPITCH + d * 32);
            const bf16x8 afr = (bf16x8){lo[0], lo[1], lo[2], lo[3], hi[0], hi[1], hi[2], hi[3]};
            o[d] = __builtin_amdgcn_mfma_f32_16x16x32_bf16(afr, bfr, o[d], 0, 0, 0);
        }
    }
    LAS float* mb = (LAS float*)(lds + NA_MOFF) + (qg * 64 + lane) * 18;
    if (kh == 1) { mb[0] = mx; mb[1] = lsum;
#pragma unroll
        for (int d = 0; d < 4; ++d)
#pragma unroll
            for (int j = 0; j < 4; ++j) mb[2 + d * 4 + j] = o[d][j]; }
    __syncthreads();
    if (kh == 0) {
        const float m1 = mb[0], l1 = mb[1];
        const float m = fmaxf(mx, m1), e0 = __builtin_amdgcn_exp2f((mx - m) * 1.4426950408889634f), e1 = __builtin_amdgcn_exp2f((m1 - m) * 1.4426950408889634f);
        const float inv = 1.f / (lsum * e0 + l1 * e1);
        bf16_t* op = MIX + (size_t)(b * LSEQ + r * 64 + c0 + n) * DM + 512 + hb * 64 + 4 * kq;
#pragma unroll
        for (int d = 0; d < 4; ++d) { float y[4];
#pragma unroll
            for (int j = 0; j < 4; ++j) y[j] = (o[d][j] * e0 + mb[2 + d * 4 + j] * e1) * inv;
            u32x2 w; w.x = pk2(y[0], y[1]); w.y = pk2(y[2], y[3]);
            *(u32x2*)(op + d * 16) = w; }
    }
    __syncthreads();
}

__device__ __forceinline__ void attention_phase(const bf16_t* __restrict__ QKV, const float* __restrict__ rpb, bf16_t* __restrict__ MIX, unsigned char* lds_g, LAS unsigned char* lds, int G, int vcu) {
    if (SEC(4)) for (int it = vcu; it < 256; it += G) {
        const int combo = it >> 5, w = it & 31, b = combo >> 1, kvh = combo & 1, g = w >> 4, qb = w & 15, h = kvh * 2 + g;
        const bf16_t* base = QKV + (size_t)b * LT * NIN;
        att::attn_dense_body(base + (size_t)(qb * 256) * NIN + h * 128, base + 1024 + kvh * 128, base + 1280 + kvh * 128,
                             MIX + (size_t)(b * LSEQ + qb * 256) * DM + h * 128, LT, (char*)lds_g);
    }
    const int per = (2048 + G - 1) / G;
    if (SEC(5)) for (int it = vcu * per; it < min(2048, (vcu + 1) * per); ++it) {
        const int combo = it >> 6, r = it & 63, b = combo >> 3, hb = combo & 7;
        na_item(QKV, rpb, MIX, b, hb, r, lds);
    }
}

__device__ __forceinline__ void convgate_phase(const bf16_t* __restrict__ U, bf16_t* __restrict__ ACT, const float* __restrict__ cw, const float* __restrict__ cb, int chunk, int G, int bx) {
    constexpr int RCH = 8, NCV = FF / 8;
    const long total = (long)(CHROWS / RCH) * NCV;
    for (long idx = (long)bx * 512 + threadIdx.x; idx < total; idx += (long)G * 512) {
        const int cv = (int)(idx % NCV), rc = (int)(idx / NCV);
        const int c = cv * 8, np = (c >> 7) * 256 + (c & 127);
        const int t0 = rc * RCH;
        float wg[3][8], wv[3][8], bg[8], bv[8];
#pragma unroll
        for (int j = 0; j < 3; ++j)
#pragma unroll
            for (int e = 0; e < 8; ++e) { wg[j][e] = cw[j * NUP + c + e]; wv[j][e] = cw[j * NUP + FF + c + e]; }
#pragma unroll
        for (int e = 0; e < 8; ++e) { bg[e] = cb[c + e]; bv[e] = cb[FF + c + e]; }
        float pg[8], pv[8], cg_[8], cv_[8], ng[8], nv[8];
        auto ld = [&](int t, float* g8, float* v8) {
            if (t < 0 || t >= CHROWS || ((t >> 12) != (t0 >> 12))) {
#pragma unroll
                for (int e = 0; e < 8; ++e) { g8[e] = 0.f; v8[e] = 0.f; }
            } else {
                const u32x4 a = *(const u32x4*)(U + (size_t)t * NUP + np), bq = *(const u32x4*)(U + (size_t)t * NUP + np + 128);
#pragma unroll
                for (int e = 0; e < 4; ++e) { g8[2 * e] = bf2f(a[e] & 0xffffu); g8[2 * e + 1] = bf2f(a[e] >> 16); v8[2 * e] = bf2f(bq[e] & 0xffffu); v8[2 * e + 1] = bf2f(bq[e] >> 16); }
            }
        };
        ld(t0 - 1, pg, pv); ld(t0, cg_, cv_);
#pragma unroll
        for (int i = 0; i < RCH; ++i) {
            ld(t0 + i + 1, ng, nv);
            float y[8];
#pragma unroll
            for (int e = 0; e < 8; ++e) {
                const float gg = pg[e] * wg[0][e] + cg_[e] * wg[1][e] + ng[e] * wg[2][e] + bg[e];
                const float vv = pv[e] * wv[0][e] + cv_[e] * wv[1][e] + nv[e] * wv[2][e] + bv[e];
                y[e] = gg / (1.f + __expf(-gg)) * vv;
            }
            u32x4 w; w.x = pk2(y[0], y[1]); w.y = pk2(y[2], y[3]); w.z = pk2(y[4], y[5]); w.w = pk2(y[6], y[7]);
            *(u32x4*)(ACT + ((size_t)chunk * CHROWS + t0 + i) * FF + c) = w;
#pragma unroll
            for (int e = 0; e < 8; ++e) { pg[e] = cg_[e]; pv[e] = cv_[e]; cg_[e] = ng[e]; cv_[e] = nv[e]; }
        }
    }
}

template <int STAGE>
__device__ __forceinline__ void fft_phase(const bf16_t* __restrict__ IN, bf16_t* __restrict__ OUT, const bf16_t* __restrict__ F, const float2* __restrict__ TW, LAS unsigned char* lds, int G, int bx) {
    constexpr int MB = STAGE == 1 ? 8 : 4, PITCH = 528;
    const int tid = threadIdx.x, wid = __builtin_amdgcn_readfirstlane(tid >> 6), lane = tid & 63, n = lane & 15, kq = lane >> 4;
    for (int it = bx; it < 1024; it += G) {
        const int g = it & 3, t = (it >> 2) & 63, b = it >> 8;
#pragma unroll
        for (int i = 0; i < 8; ++i) { const int cid = tid + 512 * i, row = cid >> 5, cc = cid & 31, ri = row >> 6, tt = row & 63;
            const size_t srow = STAGE == 1 ? ((size_t)b * 4096 + tt * 64 + t) : (((size_t)b * 64 + t) * 64 + tt);
            const u32x4 v = *(const u32x4*)(IN + srow * 2048 + g * 512 + ri * 256 + cc * 8);
            *(LAS u32x4*)(lds + row * PITCH + cc * 16) = v; }
        __syncthreads();
        f32x4 acc[MB][2];
#pragma unroll
        for (int mb = 0; mb < MB; ++mb) { acc[mb][0] = (f32x4){0.f, 0.f, 0.f, 0.f}; acc[mb][1] = (f32x4){0.f, 0.f, 0.f, 0.f}; }
#pragma unroll 1
        for (int ks = 0; ks < 4; ++ks) {
            bf16x8 bfr[2];
#pragma unroll
            for (int j = 0; j < 2; ++j) { const int nb = 2 * wid + j;
                const LAS unsigned char* p = lds + (ks * 32 + 8 * kq + (n >> 2)) * PITCH + (nb * 16 + 4 * (n & 3)) * 2;
                const s16x4 lo = vtr(p), hi = vtr(p + 4 * PITCH);
                bfr[j] = (bf16x8){lo[0], lo[1], lo[2], lo[3], hi[0], hi[1], hi[2], hi[3]}; }
#pragma unroll
            for (int mb = 0; mb < MB; ++mb) { const bf16x8 afr = *(const bf16x8*)(F + (mb * 16 + n) * 128 + ks * 32 + 8 * kq);
                acc[mb][0] = __builtin_amdgcn_mfma_f32_16x16x32_bf16(afr, bfr[0], acc[mb][0], 0, 0, 0);
                acc[mb][1] = __builtin_amdgcn_mfma_f32_16x16x32_bf16(afr, bfr[1], acc[mb][1], 0, 0, 0); }
        }
        if constexpr (STAGE == 1) {
#pragma unroll
            for (int mb = 0; mb < 4; ++mb)
#pragma unroll
                for (int jj = 0; jj < 4; ++jj) { const int k1 = mb * 16 + 4 * kq + jj; const float2 cs = TW[k1 * t];
                    bf16_t* orow = OUT + (((size_t)b * 64 + k1) * 64 + t) * 2048 + g * 512;
#pragma unroll
                    for (int j = 0; j < 2; ++j) { const float re = acc[mb][j][jj], im = acc[mb + 4][j][jj]; const int col = (2 * wid + j) * 16 + n;
                        orow[col] = (bf16_t)f2bf(re * cs.x + im * cs.y); orow[256 + col] = (bf16_t)f2bf(im * cs.x - re * cs.y); } }
        } else {
#pragma unroll
            for (int mb = 0; mb < 4; ++mb)
#pragma unroll
                for (int jj = 0; jj < 4; ++jj) { const int k2 = mb * 16 + 4 * kq + jj;
                    bf16_t* orow = OUT + ((size_t)b * 4096 + t + 64 * k2) * 1024 + g * 256;
#pragma unroll
                    for (int j = 0; j < 2; ++j) orow[(2 * wid + j) * 16 + n] = (bf16_t)f2bf(acc[mb][j][jj] * (1.f / 1024.f)); }
        }
        __syncthreads();
    }
}

#define FFN_CHUNK(l, ch) \
    if (RUN) { pg8::Gemm g{H + (size_t)(ch) * CHROWS * DM, (const bf16_t*)(ws + WS_WUP) + (size_t)(l) * NUP * DM, DM, DM, DM, 30}; pg8::StaticOrder S; S.init(CHROWS, NUP, G, bx); pg8::EpiStore E{U, NUP}; if (SEC(2)) pg8::gemm_phase(lds, g, S, E); } \
    SEAM(); \
    if (SEC(8) && RUN) convgate_phase(U, ACT, a.in[I_CW] + (size_t)(l) * 3 * NUP, a.in[I_CB] + (size_t)(l) * NUP, ch, G, bx); \
    SEAM();
#define FFN_LAYER(l) \
    if (SEC(1) && RUN) norm_mod_phase(a.out, nullptr, false, a.in[I_N2G] + (l) * DM, MOD + (size_t)(l) * 5 * 6144, 3, H, G, bx); \
    SEAM(); \
    FFN_CHUNK(l, 0) FFN_CHUNK(l, 1) \
    if (RUN) { pg8::Gemm g{ACT, (const bf16_t*)(ws + WS_WDN) + (size_t)(l) * DM * FF, FF, FF, FF, 30}; pg8::StaticOrder S; S.init(ML, DM, G, bx); pg8::EpiResid E{a.out, a.out, MOD + (size_t)(l) * 5 * 6144 + 5 * 1024}; if (SEC(6)) pg8::gemm_phase(lds, g, S, E); } \
    SEAM();
static_assert(NCH == 2, "FFN_LAYER expands two chunks");
constexpr int NPH = 10 + 4 * NCH + 10;
__global__ void __launch_bounds__(512, 2) fwd_kernel(Args a) {
    extern __shared__ __attribute__((aligned(16))) unsigned char lds_g[];
    LAS unsigned char* lds = (LAS unsigned char*)lds_g;
    const int G = gridDim.x, bx = blockIdx.x;
    const int vcu = (G % 8 == 0) ? (bx % 8) * (G / 8) + bx / 8 : bx;
    unsigned char* ws = a.ws;
    bf16_t* H = (bf16_t*)(ws + WS_H); bf16_t* QKV = (bf16_t*)(ws + WS_QKV); bf16_t* MIX = (bf16_t*)(ws + WS_MIX);
    bf16_t* U = (bf16_t*)(ws + WS_U); bf16_t* ACT = (bf16_t*)(ws + WS_ACT);
    bf16_t* Z = (bf16_t*)(ws + WS_Z); bf16_t* A1 = (bf16_t*)(ws + WS_A1); bf16_t* Y = (bf16_t*)(ws + WS_Y);
    float* MOD = (float*)(ws + WS_MOD);
    const int lo = a.ph_lo, hi = a.ph_hi;
    int ph = 0;
#if MK_SPLIT
#define SEAM() do { ++ph; } while (0)
#else
#define SEAM() do { if (lo <= ph && ph + 1 < hi) cg::this_grid().sync(); ++ph; } while (0)
#endif
#define RUN (lo <= ph && ph < hi)


    if (SEC(0) && RUN) p0_prologue(a, lds, G, bx);
    SEAM();
    if (SEC(1) && RUN) norm_mod_phase(a.in[I_X], a.in[I_CTX], true, a.in[I_N1G], MOD, 0, H, G, bx);
    SEAM();
    if (RUN) { pg8::Gemm g{H, (const bf16_t*)(ws + WS_WIN), DM, DM, DM, 30}; pg8::StaticOrder S; S.init(MQ, NIN, G, bx); pg8::EpiStore E{QKV, NIN}; if (SEC(2)) pg8::gemm_phase(lds, g, S, E); }
    SEAM();
    if (SEC(3) && RUN) qknorm_phase(QKV, a.in[I_QG], a.in[I_KG], (const float2*)(ws + WS_ROPE), G, bx);
    SEAM();
    if ((SEC(4) || SEC(5)) && RUN) attention_phase(QKV, a.in[I_RPB], MIX, lds_g, lds, G, vcu);
    SEAM();
    if (RUN) { pg8::Gemm g{MIX, (const bf16_t*)(ws + WS_WO), DM, DM, DM, 30}; pg8::StaticOrder S; S.init(ML, DM, G, bx); pg8::EpiResid E{a.in[I_X], a.out, MOD + 2048}; if (SEC(6)) pg8::gemm_phase(lds, g, S, E); }
    SEAM();
    FFN_LAYER(0);
    if (SEC(1) && RUN) norm_mod_phase(a.out, nullptr, false, a.in[I_N1G] + DM, MOD + 5 * 6144, 0, H, G, bx);
    SEAM();
    if (RUN) { pg8::Gemm g{H, (const bf16_t*)(ws + WS_DFTC), DM, 256, 256, 1}; pg8::StaticOrder S; S.init(ML, 2048, G, bx); pg8::EpiStore E{Z, 2048}; if (SEC(2)) pg8::gemm_phase(lds, g, S, E); }
    SEAM();
    if (SEC(7) && RUN) fft_phase<1>(Z, A1, (const bf16_t*)(ws + WS_F1), (const float2*)(ws + WS_TW), lds, G, bx);
    SEAM();
    if (SEC(7) && RUN) fft_phase<2>(A1, Y, (const bf16_t*)(ws + WS_F2), (const float2*)(ws + WS_TW), lds, G, bx);
    SEAM();
    if (RUN) { pg8::Gemm g{Y, (const bf16_t*)(ws + WS_WF), DM, DM, DM, 30}; pg8::StaticOrder S; S.init(ML, DM, G, bx); pg8::EpiResid E{a.out, a.out, MOD + 5 * 6144 + 2048}; if (SEC(6)) pg8::gemm_phase(lds, g, S, E); }
    SEAM();
    FFN_LAYER(1);
    if (SEC(9) && RUN) final_norm_phase(a.out, a.in[I_FG], G, bx);
#undef SEAM
#undef RUN
}

extern "C" void kernel_launch(void* const* d_in, const int* in_sizes, int n_in, void* d_out, int out_size, void* d_ws, size_t ws_size, hipStream_t stream) {
    static int grid = 0;
    if (grid == 0) {
        if (n_in != 19 || in_sizes[0] != ML * DM || out_size != ML * DM || ws_size < WS_END) { fprintf(stderr, "kernel_launch: unexpected shapes (n_in %d, in0 %d, out %d, ws %zu < %zu)\n", n_in, n_in > 0 ? in_sizes[0] : -1, out_size, ws_size, (size_t)WS_END); grid = -1; return; }
        int dev = 0, cus = 0, per_cu = 0;
        hipGetDevice(&dev);
        hipDeviceGetAttribute(&cus, hipDeviceAttributeMultiprocessorCount, dev);
        if (hipFuncSetAttribute((const void*)fwd_kernel, hipFuncAttributeMaxDynamicSharedMemorySize, LDS_BYTES) != hipSuccess) { fprintf(stderr, "kernel_launch: hipFuncSetAttribute failed\n"); grid = -1; return; }
        if (hipOccupancyMaxActiveBlocksPerMultiprocessor(&per_cu, (const void*)fwd_kernel, 512, LDS_BYTES) != hipSuccess || per_cu < 1) { fprintf(stderr, "kernel_launch: occupancy query says %d\n", per_cu); per_cu = 1; }
        (void)hipGetLastError();
        grid = cus * (per_cu > 1 ? 1 : per_cu);
        if (grid <= 0) grid = 256;
    }
    if (grid < 0) return;
    Args a{};
    for (int i = 0; i < 19; ++i) a.in[i] = (const float*)d_in[i];
    a.out = (float*)d_out; a.ws = (unsigned char*)d_ws;
#if MK_SPLIT
    for (int p = 0; p < NPH + 2; ++p) { a.ph_lo = p; a.ph_hi = p + 1; hipLaunchKernelGGL(fwd_kernel, dim3(grid), dim3(512), LDS_BYTES, stream, a); }
#else
    a.ph_lo = 0; a.ph_hi = 1000;
    void* args[] = {&a};
    hipError_t e = hipLaunchCooperativeKernel((const void*)fwd_kernel, dim3(grid), dim3(512), args, LDS_BYTES, stream);
    if (e != hipSuccess) fprintf(stderr, "kernel_launch: cooperative launch failed: %s (grid %d)\n", hipGetErrorString(e), grid);
#endif
}
```

```cpp
#include <hip/hip_runtime.h>
#include <hip/hip_cooperative_groups.h>
#include <cstdio>
#include <cstdint>
namespace cg = cooperative_groups;

#define LAS __attribute__((address_space(3)))
typedef unsigned short bf16_t;
typedef short bf16x8 __attribute__((ext_vector_type(8)));
typedef short s16x4 __attribute__((ext_vector_type(4)));
typedef short v4i16_t __attribute__((ext_vector_type(4)));
typedef float f32x4 __attribute__((ext_vector_type(4)));
typedef float f32x8 __attribute__((ext_vector_type(8)));
typedef float f32x16 __attribute__((ext_vector_type(16)));
typedef unsigned u32x4 __attribute__((ext_vector_type(4)));
typedef unsigned u32x2 __attribute__((ext_vector_type(2)));

#ifndef SECMASK
#define SECMASK 0xFFFF
#endif
#define SEC(k) ((SECMASK >> (k)) & 1)
#ifndef MK_SPLIT
#define MK_SPLIT 0
#endif

constexpr int NB = 4, LSEQ = 4096, CTXL = 256, LT = LSEQ + CTXL, MQ = NB * LT, ML = NB * LSEQ, DM = 1024, NIN = 2560, FF = 2816, NUP = 5632;
constexpr int NCH = 2, CHROWS = ML / NCH;
constexpr float EPS = 1e-6f;

constexpr size_t WS_WIN = 0;
constexpr size_t WS_WO = WS_WIN + (size_t)NIN * DM * 2;
constexpr size_t WS_WF = WS_WO + (size_t)DM * DM * 2;
constexpr size_t WS_WUP = WS_WF + (size_t)DM * DM * 2;
constexpr size_t WS_WDN = WS_WUP + 2 * (size_t)NUP * DM * 2;
constexpr size_t WS_DFTC = WS_WDN + 2 * (size_t)DM * FF * 2;
constexpr size_t WS_F1 = WS_DFTC + 512 * 256 * 2;
constexpr size_t WS_F2 = WS_F1 + 128 * 128 * 2;
constexpr size_t WS_TW = WS_F2 + 64 * 128 * 2;
constexpr size_t WS_ROPE = WS_TW + 4096 * 8;
constexpr size_t WS_BAR = WS_ROPE + 64 * 32 * 8;
constexpr size_t WS_MOD = WS_BAR + 16384;
constexpr size_t WS_H = WS_MOD + 2 * 5 * 6144 * 4 + (512 << 10);
constexpr size_t WS_R0 = WS_H + (size_t)MQ * DM * 2 + (512 << 10);
constexpr size_t WS_QKV = WS_R0, WS_MIX = WS_QKV + (size_t)MQ * NIN * 2;
constexpr size_t WS_U = WS_R0, WS_ACT = WS_U + (size_t)CHROWS * NUP * 2;
constexpr size_t WS_Z = WS_R0, WS_A1 = WS_Z + (size_t)ML * 2048 * 2, WS_Y = WS_A1 + (size_t)ML * 2048 * 2;
constexpr size_t WS_END0 = WS_ACT + (size_t)ML * FF * 2, WS_END1 = WS_Y + (size_t)ML * DM * 2, WS_END2 = WS_MIX + (size_t)ML * DM * 2;
constexpr size_t WS_END = WS_END0 > WS_END1 ? (WS_END0 > WS_END2 ? WS_END0 : WS_END2) : (WS_END1 > WS_END2 ? WS_END1 : WS_END2);
static_assert(WS_END <= 268435456ull, "workspace map exceeds 256 MiB");
static_assert(WS_H % 256 == 0 && WS_R0 % 256 == 0 && WS_MOD % 256 == 0, "alignment");

constexpr int LDS_BYTES = 147456;

__device__ __forceinline__ unsigned f2bf(float f) { unsigned u = __float_as_uint(f); return (u + 0x7fffu + ((u >> 16) & 1u)) >> 16; }
__device__ __forceinline__ unsigned pk2(float lo, float hi) { return f2bf(lo) | (f2bf(hi) << 16); }
__device__ __forceinline__ float bf2f(unsigned v) { return __uint_as_float(v << 16); }
__device__ __forceinline__ unsigned cvt_pk_bf16(float lo, float hi) { unsigned r; asm volatile("v_cvt_pk_bf16_f32 %0, %1, %2" : "=v"(r) : "v"(lo), "v"(hi)); return r; }
__device__ __forceinline__ float wave_sum(float v) {
#pragma unroll
    for (int o = 1; o < 64; o <<= 1) v += __shfl_xor(v, o);
    return v;
}

namespace pg8 {
constexpr int BM = 256, BK = 64, HALF = 128, HTB = HALF * BK * 2, STAGE_BYTES = 8 * HTB, NXCD = 8, WGM = 8;
__host__ __device__ __forceinline__ int lds_byte(int r, int c) { const int st = (r >> 4) * 2 + (c >> 5), rr = r & 15, cc = c & 31, ob = rr * 64 + cc * 2; return st * 1024 + (ob ^ (((ob >> 9) & 1) << 5)); }
__host__ __device__ __forceinline__ void stage_rc(int b, int& R, int& C) { const int st = b / 1024, sb = b % 1024, swz = sb ^ (((sb >> 9) & 1) << 5); R = (st >> 1) * 16 + swz / 64; C = (st & 1) * 32 + (swz % 64) / 2; }
__host__ __device__ __forceinline__ int perm32(int rho) { const int n = rho >> 4, i = rho & 15; return 8 * (i >> 2) + 4 * n + (i & 3); }

struct Unit { int pm, pn; };
struct Gemm { const bf16_t* A; const bf16_t* Bt; int lda, ldb, K, gs; };

struct StaticOrder {
    int nM, nN, nwg, G, c;
    __host__ __device__ void init(int M, int N, int G_, int c_) { nM = M / BM; nN = N / BM; nwg = nM * nN; G = G_; c = c_; }
    __host__ __device__ bool next(int i, Unit& u) const {
        const long L = (long)i * G + c; if (L >= nwg) return false;
        int wgid = (int)L; { const int q = nwg / NXCD, r = nwg % NXCD, xcd = wgid % NXCD, off = wgid / NXCD; wgid = (xcd < r ? xcd * (q + 1) : r * (q + 1) + (xcd - r) * q) + off; }
        const int nig = WGM * nN, gid = wgid / nig, fm = gid * WGM, gsz = (nM - fm) < WGM ? (nM - fm) : WGM;
        u.pm = fm + ((wgid % nig) % gsz); u.pn = (wgid % nig) / gsz; return true;
    }
};

struct EpiStore {
    static constexpr bool PERM = true;
    bf16_t* O; int ldc;
    __device__ __forceinline__ void operator()(const f32x4 (&acc)[2][2][4][2], const Unit& u, int wr, int wc, int fr, int fq) const {
        const int row0 = u.pm * BM + wr * 64 + fr, col0 = u.pn * BM + wc * 32 + 8 * fq;
#pragma unroll
        for (int ai = 0; ai < 2; ++ai)
#pragma unroll
            for (int m = 0; m < 4; ++m) { bf16_t* rowp = O + (size_t)(row0 + ai * HALF + m * 16) * ldc + col0;
#pragma unroll
                for (int bj = 0; bj < 2; ++bj) { const f32x4 v0 = acc[ai][bj][m][0], v1 = acc[ai][bj][m][1];
                    u32x4 w; w.x = cvt_pk_bf16(v0[0], v0[1]); w.y = cvt_pk_bf16(v0[2], v0[3]); w.z = cvt_pk_bf16(v1[0], v1[1]); w.w = cvt_pk_bf16(v1[2], v1[3]);
                    *(u32x4*)(rowp + bj * HALF) = w; } }
    }
};
struct EpiResid {
    static constexpr bool PERM = true;
    const float* R; float* O; const float* gate;
    __device__ __forceinline__ void operator()(const f32x4 (&acc)[2][2][4][2], const Unit& u, int wr, int wc, int fr, int fq) const {
        const int row0 = u.pm * BM + wr * 64 + fr, col0 = u.pn * BM + wc * 32 + 8 * fq;
        const float* gp = gate + (size_t)((u.pm * BM) >> 12) * 6144 + col0;
        f32x4 gv[2][2];
#pragma unroll
        for (int bj = 0; bj < 2; ++bj)
#pragma unroll
            for (int n = 0; n < 2; ++n) gv[bj][n] = *(const f32x4*)(gp + bj * HALF + 4 * n);
#pragma unroll
        for (int ai = 0; ai < 2; ++ai)
#pragma unroll
            for (int m = 0; m < 4; ++m) { const size_t ro = (size_t)(row0 + ai * HALF + m * 16) * DM + col0;
#pragma unroll
                for (int bj = 0; bj < 2; ++bj)
#pragma unroll
                    for (int n = 0; n < 2; ++n) { const size_t idx = ro + bj * HALF + 4 * n;
                        const f32x4 r = *(const f32x4*)(R + idx);
                        *(f32x4*)(O + idx) = r + gv[bj][n] * acc[ai][bj][m][n]; } }
    }
};

template <class Epi>
__device__ __forceinline__ void gemm_phase(LAS unsigned char* lds, const Gemm g, const StaticOrder& S, const Epi& E) {
    const int tid = threadIdx.x, wid = __builtin_amdgcn_readfirstlane(tid >> 6), lane = tid & 63, wr = wid >> 2, wc = wid & 3, fr = lane & 15, fq = lane >> 4;
    const int K = g.K, nt = K / BK;
    unsigned voffA[2], voffB[2];
#pragma unroll
    for (int i = 0; i < 2; ++i) { int R, C; stage_rc(tid * 16 + i * 8192, R, C); const int Rb = Epi::PERM ? ((R & ~31) + perm32(R & 31)) : R;
        voffA[i] = (unsigned)(R * g.lda + C) * 2u; voffB[i] = (unsigned)(Rb * g.ldb + C) * 2u; }
    const size_t kstep = (size_t)(BK * 2);
    const size_t hstepA = (size_t)HALF * g.lda * 2, hstepB = (size_t)HALF * g.ldb * 2;
    const unsigned ldsw = (unsigned)wid * 1024u;
    const int aoff = lds_byte(wr * 64 + fr, fq * 8), boff = lds_byte(wc * 32 + fr, fq * 8);
    const int gmask = (1 << g.gs) - 1;
#define PG8_APTR(u) ((const char*)g.A + (size_t)(u).pm * 2 * hstepA + (size_t)((u).pn >> g.gs) * (size_t)K * 2)
#define PG8_BPTR(u) ((const char*)g.Bt + (size_t)((u).pn & gmask) * 2 * hstepB)
#define PG8_SA(b, h) (((b) * 2 + (h)) * HTB)
#define PG8_SB(b, h) ((4 + (b) * 2 + (h)) * HTB)
#define PG8_STAGE(bufoff, gbase, voff) do { _Pragma("unroll") for (int _i = 0; _i < 2; ++_i) \
        __builtin_amdgcn_global_load_lds((const unsigned*)((const char*)(gbase) + (voff)[_i]), (LAS unsigned*)(lds + (bufoff) + ldsw + _i * 8192), 16, 0, 0); } while (0)
#define PG8_LDA(dst, b, h) do { _Pragma("unroll") for (int m = 0; m < 4; ++m) _Pragma("unroll") for (int k = 0; k < 2; ++k) dst[m][k] = *(const LAS bf16x8*)(lds + PG8_SA(b, h) + aoff + m * 2048 + k * 1024); } while (0)
#define PG8_LDB(dst, b, h) do { _Pragma("unroll") for (int n = 0; n < 2; ++n) _Pragma("unroll") for (int k = 0; k < 2; ++k) dst[n][k] = *(const LAS bf16x8*)(lds + PG8_SB(b, h) + boff + n * 2048 + k * 1024); } while (0)
#define PG8_MMA(ai, bj, At, Bt) do { __builtin_amdgcn_s_setprio(1); _Pragma("unroll") for (int m = 0; m < 4; ++m) _Pragma("unroll") for (int n = 0; n < 2; ++n) _Pragma("unroll") for (int k = 0; k < 2; ++k) \
        acc[ai][bj][m][n] = __builtin_amdgcn_mfma_f32_16x16x32_bf16(Bt[n][k], At[m][k], acc[ai][bj][m][n], 0, 0, 0); __builtin_amdgcn_s_setprio(0); } while (0)
#define PG8_WAIT_V(n) asm volatile("s_waitcnt vmcnt(" #n ")" ::: "memory")
#define PG8_WAIT_L(n) asm volatile("s_waitcnt lgkmcnt(" #n ")" ::: "memory")
#define PG8_BAR __builtin_amdgcn_s_barrier()
#define PG8_SCHED __builtin_amdgcn_sched_barrier(0)
    Unit cur, nxt; int ui = 0;
    if (!S.next(0, cur)) return;
    f32x4 acc[2][2][4][2];
#pragma unroll
    for (int a = 0; a < 2; ++a)
#pragma unroll
        for (int b = 0; b < 2; ++b)
#pragma unroll
            for (int m = 0; m < 4; ++m)
#pragma unroll
                for (int n = 0; n < 2; ++n) acc[a][b][m][n] = (f32x4){0.f, 0.f, 0.f, 0.f};
    bf16x8 At[4][2], B0[2][2], B1[2][2];
    const char* cA = PG8_APTR(cur); const char* cB = PG8_BPTR(cur);
    PG8_STAGE(PG8_SB(0, 0), cB, voffB); PG8_STAGE(PG8_SB(0, 1), cB + hstepB, voffB); PG8_STAGE(PG8_SA(0, 0), cA, voffA); PG8_STAGE(PG8_SA(0, 1), cA + hstepA, voffA);
    if (wr == 1) PG8_BAR;
    PG8_WAIT_V(2); PG8_BAR;
    PG8_STAGE(PG8_SB(1, 0), cB + kstep, voffB); PG8_STAGE(PG8_SA(1, 0), cA + kstep, voffA); PG8_STAGE(PG8_SB(1, 1), cB + hstepB + kstep, voffB);
    PG8_WAIT_V(6); PG8_BAR;
    for (;;) {
        const bool has_next = S.next(ui + 1, nxt);
        const char* nA = has_next ? PG8_APTR(nxt) : cA; const char* nB = has_next ? PG8_BPTR(nxt) : cB;
        for (int t = 0; t < nt; t += 2) {
            const bool last = (t == nt - 2);
            const char* a1 = cA + (size_t)(t + 1) * kstep;
            const char* a2 = last ? nA : cA + (size_t)(t + 2) * kstep; const char* b2 = last ? nB : cB + (size_t)(t + 2) * kstep;
            const char* a3 = a2 + kstep; const char* b3 = b2 + kstep;
            PG8_LDB(B0, 0, 0); PG8_LDB(B1, 0, 1); PG8_SCHED; PG8_LDA(At, 0, 0); PG8_STAGE(PG8_SA(1, 1), a1 + hstepA, voffA);
            PG8_WAIT_V(8); PG8_WAIT_L(0); PG8_BAR; PG8_MMA(0, 0, At, B0); PG8_MMA(0, 1, At, B1); PG8_BAR; PG8_SCHED;
            PG8_LDA(At, 0, 1); PG8_STAGE(PG8_SB(0, 0), b2, voffB); PG8_STAGE(PG8_SB(0, 1), b2 + hstepB, voffB); PG8_STAGE(PG8_SA(0, 0), a2, voffA);
            PG8_WAIT_V(8); PG8_WAIT_L(0); PG8_BAR; PG8_MMA(1, 0, At, B0); PG8_MMA(1, 1, At, B1); PG8_BAR; PG8_SCHED;
            PG8_LDB(B0, 1, 0); PG8_LDB(B1, 1, 1); PG8_SCHED; PG8_LDA(At, 1, 0); PG8_STAGE(PG8_SA(0, 1), a2 + hstepA, voffA);
            PG8_WAIT_V(8); PG8_WAIT_L(0); PG8_BAR; PG8_MMA(0, 0, At, B0); PG8_MMA(0, 1, At, B1); PG8_BAR; PG8_SCHED;
            PG8_LDA(At, 1, 1); PG8_STAGE(PG8_SB(1, 0), b3, voffB); PG8_STAGE(PG8_SB(1, 1), b3 + hstepB, voffB); PG8_STAGE(PG8_SA(1, 0), a3, voffA);
            PG8_WAIT_V(8); PG8_WAIT_L(0); PG8_BAR; PG8_MMA(1, 0, At, B0); PG8_MMA(1, 1, At, B1); PG8_BAR; PG8_SCHED;
        }
        if (wr == 0) PG8_BAR;
        E(acc, cur, wr, wc, fr, fq);
        if (!has_next) break;
#pragma unroll
        for (int a = 0; a < 2; ++a)
#pragma unroll
            for (int b = 0; b < 2; ++b)
#pragma unroll
                for (int m = 0; m < 4; ++m)
#pragma unroll
                    for (int n = 0; n < 2; ++n) acc[a][b][m][n] = (f32x4){0.f, 0.f, 0.f, 0.f};
        cur = nxt; cA = nA; cB = nB; ++ui;
        if (wr == 1) PG8_BAR;
    }
    PG8_WAIT_V(0);
    PG8_BAR;
#undef PG8_APTR
#undef PG8_BPTR
#undef PG8_SA
#undef PG8_SB
#undef PG8_STAGE
#undef PG8_LDA
#undef PG8_LDB
#undef PG8_MMA
#undef PG8_WAIT_V
#undef PG8_WAIT_L
#undef PG8_BAR
#undef PG8_SCHED
}
}

namespace att {
constexpr int D = 128, NW = 8, QBLK = 32, KVBLK = 64;
constexpr float SCALE = 0.088388347648318440f;
constexpr float THR = 8.f;
constexpr int LDQ = NIN, LDK = NIN, LDO = DM;
constexpr size_t SHM_V = KVBLK * D * 2, SHM_K = KVBLK * D * 2, SHM_ATTN = 2 * SHM_V + 2 * SHM_K + NW * 64 * 4;
#define KSWZ(row, colB) ((row) * 256 + ((colB) ^ (((row) & 7) << 4)))
#define SBAR() __builtin_amdgcn_sched_barrier(0)
__device__ __forceinline__ int crow(int r, int hi) { return (r & 3) + 8 * (r >> 2) + 4 * hi; }
__device__ __forceinline__ unsigned cvtpk(float lo, float hi) { unsigned r; asm volatile("v_cvt_pk_bf16_f32 %0, %1, %2" : "=v"(r) : "v"(lo), "v"(hi)); return r; }

__device__ __forceinline__ void partialSM(f32x16& p0, f32x16& p1, float& m_reg, float& mn, float& alpha) {
  constexpr float C = SCALE * 1.4426950408889634f;
  float pmax = p0[0];
#pragma unroll
  for (int r = 1; r < 16; ++r) pmax = fmaxf(pmax, p0[r]);
#pragma unroll
  for (int r = 0; r < 16; ++r) pmax = fmaxf(pmax, p1[r]);
  { auto rr = __builtin_amdgcn_permlane32_swap(__float_as_uint(pmax), __float_as_uint(pmax), false, false);
    pmax = fmaxf(__uint_as_float(rr[0]), __uint_as_float(rr[1])); }
  if (__builtin_expect(__all(pmax - m_reg <= THR / SCALE), 1)) { mn = m_reg; alpha = 1.f; }
  else { mn = fmaxf(m_reg, pmax); alpha = __builtin_amdgcn_exp2f((m_reg - mn) * C); m_reg = mn; }
  float mnC = -mn * C;
#pragma unroll
  for (int r = 0; r < 16; ++r) p0[r] = fmaf(p0[r], C, mnC);
#pragma unroll
  for (int r = 0; r < 16; ++r) p1[r] = fmaf(p1[r], C, mnC);
#pragma unroll
  for (int r = 0; r < 16; ++r) p0[r] = __builtin_amdgcn_exp2f(p0[r]);
}
__device__ __forceinline__ void finishSM(f32x16& p0, f32x16& p1, float alpha, float& l_reg, bf16x8& pa0, bf16x8& pa1, bf16x8& pa2, bf16x8& pa3) {
#pragma unroll
  for (int r = 0; r < 16; ++r) p1[r] = __builtin_amdgcn_exp2f(p1[r]);
  float ps = 0;
#pragma unroll
  for (int r = 0; r < 16; ++r) ps += p0[r];
#pragma unroll
  for (int r = 0; r < 16; ++r) ps += p1[r];
  { auto rr = __builtin_amdgcn_permlane32_swap(__float_as_uint(ps), __float_as_uint(ps), false, false);
    ps = __uint_as_float(rr[0]) + __uint_as_float(rr[1]); }
  l_reg = l_reg * alpha + ps;
#define PK4(P, BASE, OUT) do { unsigned a0 = cvtpk(P[BASE + 0], P[BASE + 1]), a1 = cvtpk(P[BASE + 2], P[BASE + 3]);   \
    unsigned b0 = cvtpk(P[BASE + 4], P[BASE + 5]), b1 = cvtpk(P[BASE + 6], P[BASE + 7]);                              \
    auto r0 = __builtin_amdgcn_permlane32_swap(a0, b0, false, false); auto r1 = __builtin_amdgcn_permlane32_swap(a1, b1, false, false); \
    u32x4 w = {r0[0], r1[0], r0[1], r1[1]}; OUT = *reinterpret_cast<bf16x8*>(&w); } while (0)
  PK4(p0, 0, pa0); PK4(p0, 8, pa1); PK4(p1, 0, pa2); PK4(p1, 8, pa3);
#undef PK4
}
__device__ __forceinline__ void qkt(f32x16& p0, f32x16& p1, const bf16_t* Ks, const bf16x8* qr, int r32, int hi) {
  p0 = f32x16{}; p1 = f32x16{};
#pragma unroll
  for (int d0 = 0; d0 < 8; ++d0) { int cb = (d0 * 16 + hi * 8) * 2;
    bf16x8 b0 = *reinterpret_cast<const bf16x8*>((const char*)Ks + KSWZ(r32, cb));
    bf16x8 b1 = *reinterpret_cast<const bf16x8*>((const char*)Ks + KSWZ(32 + r32, cb));
    p0 = __builtin_amdgcn_mfma_f32_32x32x16_bf16(b0, qr[d0], p0, 0, 0, 0);
    p1 = __builtin_amdgcn_mfma_f32_32x32x16_bf16(b1, qr[d0], p1, 0, 0, 0); }
}
__device__ __forceinline__ int v_st(int k, int c) { const int kk = (k & ~0xC) | ((k & 4) << 1) | ((k & 8) >> 1); return ((kk >> 3) * 4 + (c >> 5)) * 512 + ((kk & 7) * 32 + (c & 31)) * 2; }
__device__ __forceinline__ int v_rd_base(int lane) { return ((lane & 3) << 3) | (((lane >> 2) & 3) << 6) | (((lane >> 4) & 1) << 5) | (((lane >> 5) & 1) << 8); }
constexpr int v_rd_off(int d0, int ks, int half) { return d0 * 512 + ks * 4096 + half * 2048; }
template <int OFF> __device__ __forceinline__ s16x4 tr_read(int vb) {
  s16x4 r; asm volatile("ds_read_b64_tr_b16 %0, %1 offset:%2" : "=&v"(r) : "v"(vb), "i"(OFF) : "memory"); return r;
}
template <int D0> __device__ __forceinline__ void pv_one(f32x16& od, int vb, bf16x8 pa0, bf16x8 pa1, bf16x8 pa2, bf16x8 pa3) {
  const s16x4 l0 = tr_read<v_rd_off(D0, 0, 0)>(vb), h0 = tr_read<v_rd_off(D0, 0, 1)>(vb), l1 = tr_read<v_rd_off(D0, 1, 0)>(vb), h1 = tr_read<v_rd_off(D0, 1, 1)>(vb);
  const s16x4 l2 = tr_read<v_rd_off(D0, 2, 0)>(vb), h2 = tr_read<v_rd_off(D0, 2, 1)>(vb), l3 = tr_read<v_rd_off(D0, 3, 0)>(vb), h3 = tr_read<v_rd_off(D0, 3, 1)>(vb);
  asm volatile("s_waitcnt lgkmcnt(0)" ::: "memory"); SBAR();
#define PK(L, H) (bf16x8){L[0], L[1], L[2], L[3], H[0], H[1], H[2], H[3]}
  od = __builtin_amdgcn_mfma_f32_32x32x16_bf16(pa0, PK(l0, h0), od, 0, 0, 0);
  od = __builtin_amdgcn_mfma_f32_32x32x16_bf16(pa1, PK(l1, h1), od, 0, 0, 0);
  od = __builtin_amdgcn_mfma_f32_32x32x16_bf16(pa2, PK(l2, h2), od, 0, 0, 0);
  od = __builtin_amdgcn_mfma_f32_32x32x16_bf16(pa3, PK(l3, h3), od, 0, 0, 0);
#undef PK
}
__device__ __forceinline__ void pv_d0(f32x16* o, int vb, bf16x8 pa0, bf16x8 pa1, bf16x8 pa2, bf16x8 pa3) {
  pv_one<0>(o[0], vb, pa0, pa1, pa2, pa3); pv_one<1>(o[1], vb, pa0, pa1, pa2, pa3); pv_one<2>(o[2], vb, pa0, pa1, pa2, pa3); pv_one<3>(o[3], vb, pa0, pa1, pa2, pa3);
}

__device__ __forceinline__ void attn_dense_body(const bf16_t* __restrict__ Qb, const bf16_t* __restrict__ Kh, const bf16_t* __restrict__ Vh,
                                                bf16_t* __restrict__ Ob, int seq, char* lds) {
  const int tid = threadIdx.x, wid = tid >> 6, lane = tid & 63, r32 = lane & 31, hi = lane >> 5;
  bf16_t* V_lds = (bf16_t*)lds; bf16_t* K_lds = (bf16_t*)(lds + 2 * SHM_V);
  float* ws = (float*)(lds + 2 * SHM_V + 2 * SHM_K) + wid * 64; float* li_l = ws; float* al_l = ws + 32;
  float m_reg = -1e30f, l_reg = 0; f32x16 o[4] = {}; bf16x8 qr[8];
  const bf16_t* Qw = Qb + (long)(wid * QBLK + r32) * LDQ + hi * 8;
#pragma unroll
  for (int d0 = 0; d0 < 8; ++d0) qr[d0] = *reinterpret_cast<const bf16x8*>(Qw + d0 * 16);
  const int sr = tid >> 4, sc = (tid & 15) * 8, vst0 = v_st(sr, sc), vst1 = v_st(32 + sr, sc);
  const int vb0 = (int)(uintptr_t)V_lds + v_rd_base(lane);
  struct { bf16x8 vs0, vs1, ks0, ks1; } sr_[2];
#define SLOAD(i, k0) do { sr_[i].vs0 = *reinterpret_cast<const bf16x8*>(&Vh[(long)((k0) + sr) * LDK + sc]); sr_[i].vs1 = *reinterpret_cast<const bf16x8*>(&Vh[(long)((k0) + 32 + sr) * LDK + sc]); \
    sr_[i].ks0 = *reinterpret_cast<const bf16x8*>(&Kh[(long)((k0) + sr) * LDK + sc]); sr_[i].ks1 = *reinterpret_cast<const bf16x8*>(&Kh[(long)((k0) + 32 + sr) * LDK + sc]); } while (0)
#define SWRITE(b, i) do { *(bf16x8*)((char*)V_lds + (b) * SHM_V + vst0) = sr_[i].vs0;          \
    *(bf16x8*)((char*)V_lds + (b) * SHM_V + vst1) = sr_[i].vs1; int kc = sc * 2;               \
    *(bf16x8*)((char*)K_lds + (b) * SHM_K + KSWZ(sr, kc)) = sr_[i].ks0;                       \
    *(bf16x8*)((char*)K_lds + (b) * SHM_K + KSWZ(32 + sr, kc)) = sr_[i].ks1; } while (0)
#define SWAIT() asm volatile("s_waitcnt vmcnt(4)" ::: "memory")
#define RESC(a) do { if (__any((a) < 1.f)) { if (hi == 0) al_l[r32] = (a); asm volatile("s_waitcnt lgkmcnt(0)" ::: "memory"); \
    _Pragma("unroll") for (int d = 0; d < 4; ++d) _Pragma("unroll") for (int r = 0; r < 16; ++r) o[d][r] *= al_l[crow(r, hi)]; } } while (0)
  f32x16 pA0, pA1, pB0, pB1; float mnA, mnB, alA, alB; bf16x8 pa0, pa1, pa2, pa3; const int NT = seq / KVBLK;
  constexpr int SE = 0, SO = 1;
  SLOAD(SE, 0); asm volatile("s_waitcnt vmcnt(0)" ::: "memory"); SWRITE(0, SE); __syncthreads();
  qkt(pA0, pA1, K_lds, qr, r32, hi); partialSM(pA0, pA1, m_reg, mnA, alA);
  SLOAD(SO, KVBLK); if (2 < NT) SLOAD(SE, 2 * KVBLK);
  SWAIT(); SWRITE(1, SO); __syncthreads();
  for (int j = 1; j + 1 < NT; j += 2) {
    SBAR(); qkt(pB0, pB1, (bf16_t*)((char*)K_lds + SHM_K), qr, r32, hi);
    finishSM(pA0, pA1, alA, l_reg, pa0, pa1, pa2, pa3); SBAR();
    SLOAD(SO, (j + 2) * KVBLK); SBAR();
    pv_d0(o, vb0, pa0, pa1, pa2, pa3); partialSM(pB0, pB1, m_reg, mnB, alB);
    __syncthreads(); SWAIT(); SWRITE(0, SE);
    RESC(alB); __syncthreads();
    SBAR(); qkt(pA0, pA1, K_lds, qr, r32, hi);
    finishSM(pB0, pB1, alB, l_reg, pa0, pa1, pa2, pa3); SBAR();
    if (j + 3 < NT) SLOAD(SE, (j + 3) * KVBLK); SBAR();
    pv_d0(o, vb0 + (int)SHM_V, pa0, pa1, pa2, pa3); partialSM(pA0, pA1, m_reg, mnA, alA);
    __syncthreads(); SWAIT(); SWRITE(1, SO);
    RESC(alA); __syncthreads();
  }
  SBAR(); qkt(pB0, pB1, (bf16_t*)((char*)K_lds + SHM_K), qr, r32, hi);
  finishSM(pA0, pA1, alA, l_reg, pa0, pa1, pa2, pa3); SBAR();
  pv_d0(o, vb0, pa0, pa1, pa2, pa3); partialSM(pB0, pB1, m_reg, mnB, alB);
  __syncthreads(); RESC(alB);
  finishSM(pB0, pB1, alB, l_reg, pa0, pa1, pa2, pa3); SBAR();
  pv_d0(o, vb0 + (int)SHM_V, pa0, pa1, pa2, pa3);
  if (hi == 0) li_l[r32] = l_reg; asm volatile("s_waitcnt lgkmcnt(0)" ::: "memory");
  float rli[16];
#pragma unroll
  for (int r = 0; r < 16; ++r) rli[r] = __builtin_amdgcn_rcpf(li_l[crow(r, hi)]);
  bf16_t* Ow = Ob + (long)(wid * QBLK) * LDO;
#pragma unroll
  for (int r = 0; r < 16; ++r) { int orow = crow(r, hi);
#pragma unroll
    for (int d0 = 0; d0 < 4; ++d0) Ow[(long)orow * LDO + d0 * 32 + r32] = (bf16_t)f2bf(o[d0][r] * rli[r]); }
  __syncthreads();
#undef SLOAD
#undef SWRITE
#undef SWAIT
#undef RESC
}
}

#define XB_TMO      128
#define XB_XCNT(j)  (256  + 64 * (j))
#define XB_XSUB(j)  (1280 + 64 * (j))
#define XB_XGEN(j)  (2304 + 64 * (j))
#define XB_TOP      3328
#define XB_TOPGEN   3392
#define XCD_BAR_WORDS 3456
#define XB_SPIN_CAP (1u << 18)
static_assert(XCD_BAR_WORDS * 4 <= 16384, "barrier words");
__device__ __forceinline__ unsigned xb_ld(unsigned* p)              { return __hip_atomic_load(p, __ATOMIC_RELAXED, __HIP_MEMORY_SCOPE_AGENT); }
__device__ __forceinline__ unsigned xb_add(unsigned* p, unsigned v) { return __hip_atomic_fetch_add(p, v, __ATOMIC_RELAXED, __HIP_MEMORY_SCOPE_AGENT); }
__device__ __forceinline__ unsigned xb_xcc_id() { return (unsigned)__builtin_amdgcn_s_getreg((3 << 11) | 20) & 0xFu; }
#define XB_SPIN(cond, bar) do { unsigned _sp = 0; while (cond) { __builtin_amdgcn_s_sleep(1); \
    if ((++_sp & 255u) == 0u) { if (xb_ld(&(bar)[XB_TMO])) break; if (_sp > XB_SPIN_CAP) { atomicAdd(&(bar)[XB_TMO], 1u); break; } } } } while (0)
struct XcdBarrier { unsigned* bar; unsigned x; volatile LAS unsigned* st; };
__device__ __forceinline__ XcdBarrier xcd_barrier_post(unsigned* bar, volatile LAS unsigned* st) {
    XcdBarrier b; b.bar = bar; b.x = xb_xcc_id(); b.st = st;
    if (threadIdx.x == 0) (void)xb_add(&bar[XB_XCNT(b.x)], 1u);
    return b;
}
__device__ __forceinline__ void xcd_barrier_complete(unsigned* bar, unsigned x, unsigned& nloc, unsigned& nx) {
    const unsigned G = gridDim.x * gridDim.y * gridDim.z;
    unsigned sum, cnt, mine, sp = 0u;
    for (;;) {
        sum = 0u; cnt = 0u; mine = 0u;
#pragma unroll
        for (unsigned j = 0; j < 16; ++j) { const unsigned c = xb_ld(&bar[XB_XCNT(j)]); sum += c; cnt += (c > 0u) ? 1u : 0u; mine = (j == x) ? c : mine; }
        if (sum == G) break;
        __builtin_amdgcn_s_sleep(1);
        if ((++sp & 255u) == 0u) { if (xb_ld(&bar[XB_TMO])) break; if (sp > XB_SPIN_CAP) { atomicAdd(&bar[XB_TMO], 1u); break; } }
    }
    nloc = mine > 0u ? mine : 1u; nx = cnt > 0u ? cnt : 1u;
}
__device__ __forceinline__ void xcd_barrier(const XcdBarrier& b) {
    asm volatile("s_waitcnt vmcnt(0)" ::: "memory");
    __syncthreads();
    if (threadIdx.x == 0) {
        unsigned* bar = b.bar;
        __builtin_amdgcn_s_waitcnt(0);
        unsigned nloc = b.st[0], nx = b.st[1];
        if (nloc == 0u) { xcd_barrier_complete(bar, b.x, nloc, nx); b.st[0] = nloc; b.st[1] = nx; }
        const unsigned old = xb_add(&bar[XB_XSUB(b.x)], 1u);
        const unsigned gen = old / nloc;
        if (old + 1u == (gen + 1u) * nloc) {
            __builtin_amdgcn_fence(__ATOMIC_RELEASE, "agent");
            asm volatile("s_waitcnt vmcnt(0)" ::: "memory");
            const unsigned og = xb_add(&bar[XB_TOP], 1u);
            const unsigned tg = og / nx;
            if (og + 1u == (tg + 1u) * nx) xb_add(&bar[XB_TOPGEN], 1u);
            else XB_SPIN(xb_ld(&bar[XB_TOPGEN]) == tg, bar);
            __builtin_amdgcn_fence(__ATOMIC_ACQUIRE, "agent");
            xb_add(&bar[XB_XGEN(b.x)], 1u);
            asm volatile("s_waitcnt vmcnt(0)" ::: "memory");
        } else {
            XB_SPIN(xb_ld(&bar[XB_XGEN(b.x)]) == gen, bar);
            __builtin_amdgcn_fence(__ATOMIC_ACQUIRE, "agent");
            asm volatile("s_waitcnt vmcnt(0)" ::: "memory");
        }
    }
    __syncthreads();
}

struct Args { const float* in[19]; float* out; unsigned char* ws; int ph_lo, ph_hi; };
enum { I_X = 0, I_C, I_CTX, I_CCTX, I_MODW, I_MODB, I_N1G, I_N2G, I_WIN, I_WOUT, I_QG, I_KG, I_RPB, I_FW, I_WUP, I_CW, I_CB, I_WDN, I_FG };

__device__ __forceinline__ s16x4 vtr(const LAS unsigned char* p) { return __builtin_bit_cast(s16x4, __builtin_amdgcn_ds_read_tr16_b64_v4i16((LAS v4i16_t*)p)); }

__device__ __forceinline__ int up_perm(int n) { return n < FF ? ((n >> 7) * 256 + (n & 127)) : ((((n - FF) >> 7) * 256) + 128 + ((n - FF) & 127)); }

__device__ __forceinline__ void transpose_tile(const float* __restrict__ W, int N, bf16_t* __restrict__ WT, int ldt, int tk, int tn, bool perm, LAS float* scr) {
    const int tid = threadIdx.x;
#pragma unroll
    for (int i = 0; i < 8; ++i) { const int kk = (tid >> 6) + 8 * i, nn = tid & 63; scr[kk * 65 + nn] = W[(size_t)(tk * 64 + kk) * N + tn * 64 + nn]; }
    __syncthreads();
    { const int nn = tid >> 3, kc = tid & 7; float v[8];
#pragma unroll
      for (int e = 0; e < 8; ++e) v[e] = scr[(kc * 8 + e) * 65 + nn];
      const int n = tn * 64 + nn, nrow = perm ? up_perm(n) : n;
      u32x4 w; w.x = pk2(v[0], v[1]); w.y = pk2(v[2], v[3]); w.z = pk2(v[4], v[5]); w.w = pk2(v[6], v[7]);
      *(u32x4*)(WT + (size_t)nrow * ldt + tk * 64 + kc * 8) = w; }
    __syncthreads();
}

__device__ __forceinline__ void adaln_item(const Args& a, int item, float* MOD, LAS float* sv, LAS float* red) {
    const int tid = threadIdx.x, l = item / 96, j = item % 96;
    const float* c = a.in[I_C]; const float* cc = a.in[I_CCTX];
    for (int idx = tid; idx < 5 * 1024; idx += 512) { const int r = idx >> 10, k = idx & 1023; const float v = r < 4 ? c[r * 1024 + k] : cc[k]; sv[idx] = v / (1.f + __expf(-v)); }
    __syncthreads();
    const int col = tid & 63, kg = tid >> 6;
    const float* w = a.in[I_MODW] + (size_t)l * 1024 * 6144 + j * 64 + col;
    float acc[5] = {0.f, 0.f, 0.f, 0.f, 0.f};
    for (int k = kg * 128; k < kg * 128 + 128; ++k) { const float wv = w[(size_t)k * 6144];
#pragma unroll
        for (int r = 0; r < 5; ++r) acc[r] += sv[r * 1024 + k] * wv; }
#pragma unroll
    for (int r = 0; r < 5; ++r) red[(kg * 5 + r) * 64 + col] = acc[r];
    __syncthreads();
    if (tid < 320) { const int r = tid >> 6, cl = tid & 63; float s = 0.f;
#pragma unroll
        for (int g = 0; g < 8; ++g) s += red[(g * 5 + r) * 64 + cl];
        MOD[(size_t)(l * 5 + r) * 6144 + j * 64 + cl] = s + a.in[I_MODB][l * 6144 + j * 64 + cl]; }
    __syncthreads();
}

__device__ __forceinline__ void p0_prologue(const Args& a, LAS unsigned char* lds, int G, int bx) {
    unsigned char* ws = a.ws;
    const int tid = threadIdx.x;
    {
        const long gt = (long)bx * 512 + tid, GT = (long)G * 512;
        bf16_t* dftc = (bf16_t*)(ws + WS_DFTC);
        for (long i = gt; i < 512 * 256; i += GT) { const int row = (int)(i >> 8), n = (int)(i & 255), ri = row >> 8, m = row & 255; float s, c; sincospif((float)((m * n) & 255) * (1.f / 128.f), &s, &c); dftc[i] = (bf16_t)f2bf(ri ? -s : c); }
        bf16_t* f1 = (bf16_t*)(ws + WS_F1);
        for (long i = gt; i < 128 * 128; i += GT) { const int row = (int)(i >> 7), col = (int)(i & 127), ro = row >> 6, k1 = row & 63, ri = col >> 6, t1 = col & 63; float s, c; sincospif((float)((k1 * t1) & 63) * (1.f / 32.f), &s, &c);
            const float v = (ro == 0) ? (ri == 0 ? c : s) : (ri == 0 ? -s : c); f1[i] = (bf16_t)f2bf(v); }
        bf16_t* f2 = (bf16_t*)(ws + WS_F2);
        for (long i = gt; i < 64 * 128; i += GT) { const int k2 = (int)(i >> 7), col = (int)(i & 127), ri = col >> 6, t2 = col & 63; float s, c; sincospif((float)((k2 * t2) & 63) * (1.f / 32.f), &s, &c); f2[i] = (bf16_t)f2bf(ri == 0 ? c : s); }
        float2* tw = (float2*)(ws + WS_TW);
        for (long i = gt; i < 4096; i += GT) { float s, c; sincospif((float)i * (1.f / 2048.f), &s, &c); tw[i] = make_float2(c, s); }
        float2* rope = (float2*)(ws + WS_ROPE);
        for (long i = gt; i < 64 * 32; i += GT) { const int pos = (int)(i >> 5), j = (int)(i & 31); const float fr = powf(10000.f, -(float)j / 32.f); const float ang = (float)pos * fr; rope[i] = make_float2(cosf(ang), sinf(ang)); }
    }
    LAS float* scr = (LAS float*)lds;
    for (int it = bx; it < 192; it += G) adaln_item(a, it, (float*)(ws + WS_MOD), scr, scr + 5 * 1024);
    for (int t = bx; t < 5376; t += G) {
        if (t < 640) transpose_tile(a.in[I_WIN], NIN, (bf16_t*)(ws + WS_WIN), DM, t / 40, t % 40, false, scr);
        else if (t < 896) { const int u = t - 640; transpose_tile(a.in[I_WOUT], DM, (bf16_t*)(ws + WS_WO), DM, u / 16, u % 16, false, scr); }
        else if (t < 1152) { const int u = t - 896; transpose_tile(a.in[I_FW], DM, (bf16_t*)(ws + WS_WF), DM, u / 16, u % 16, false, scr); }
        else if (t < 3968) { const int u = t - 1152, l = u / 1408, v = u % 1408; transpose_tile(a.in[I_WUP] + (size_t)l * DM * NUP, NUP, (bf16_t*)(ws + WS_WUP) + (size_t)l * NUP * DM, DM, v / 88, v % 88, true, scr); }
        else { const int u = t - 3968, l = u / 704, v = u % 704; transpose_tile(a.in[I_WDN] + (size_t)l * FF * DM, DM, (bf16_t*)(ws + WS_WDN) + (size_t)l * DM * FF, FF, v / 16, v % 16, false, scr); }
    }
}

__device__ __forceinline__ void norm_mod_phase(const float* __restrict__ xl, const float* __restrict__ xc, bool with_ctx, const float* __restrict__ gain,
                                               const float* __restrict__ MODl, int chunk, bf16_t* __restrict__ out, int G, int bx) {
    const int wid = threadIdx.x >> 6, lane = threadIdx.x & 63;
    const int nrows = with_ctx ? MQ : ML;
    for (int row = bx * 8 + wid; row < nrows; row += G * 8) {
        int b, t; if (with_ctx) { b = row / LT; t = row - b * LT; } else { b = row >> 12; t = row & 4095; }
        const float* src = (t < LSEQ) ? xl + ((size_t)b * LSEQ + t) * DM : xc + ((size_t)b * CTXL + (t - LSEQ)) * DM;
        const float* mrow = MODl + (size_t)((t < LSEQ) ? b : 4) * 6144 + chunk * 1024;
        f32x4 v[4]; float ss = 0.f;
#pragma unroll
        for (int j = 0; j < 4; ++j) { v[j] = *(const f32x4*)(src + j * 256 + lane * 4); ss += v[j][0] * v[j][0] + v[j][1] * v[j][1] + v[j][2] * v[j][2] + v[j][3] * v[j][3]; }
        ss = wave_sum(ss);
        const float rstd = rsqrtf(ss * (1.f / 1024.f) + EPS);
#pragma unroll
        for (int j = 0; j < 4; ++j) { const int c = j * 256 + lane * 4;
            const f32x4 g = *(const f32x4*)(gain + c), sh = *(const f32x4*)(mrow + c), sc = *(const f32x4*)(mrow + 1024 + c);
            const f32x4 y = (v[j] * rstd * g) * (sc + 1.f) + sh;
            u32x2 w; w.x = pk2(y[0], y[1]); w.y = pk2(y[2], y[3]);
            *(u32x2*)(out + (size_t)row * DM + c) = w; }
    }
}

__device__ __forceinline__ void final_norm_phase(float* __restrict__ x, const float* __restrict__ gain, int G, int bx) {
    const int wid = threadIdx.x >> 6, lane = threadIdx.x & 63;
    for (int row = bx * 8 + wid; row < ML; row += G * 8) {
        float* src = x + (size_t)row * DM;
        f32x4 v[4]; float ss = 0.f;
#pragma unroll
        for (int j = 0; j < 4; ++j) { v[j] = *(const f32x4*)(src + j * 256 + lane * 4); ss += v[j][0] * v[j][0] + v[j][1] * v[j][1] + v[j][2] * v[j][2] + v[j][3] * v[j][3]; }
        ss = wave_sum(ss);
        const float rstd = rsqrtf(ss * (1.f / 1024.f) + EPS);
#pragma unroll
        for (int j = 0; j < 4; ++j) { const int c = j * 256 + lane * 4; const f32x4 g = *(const f32x4*)(gain + c); *(f32x4*)(src + c) = v[j] * rstd * g; }
    }
}

__device__ __forceinline__ void qknorm_phase(bf16_t* __restrict__ QKV, const float* __restrict__ qg, const float* __restrict__ kg, const float2* __restrict__ rope, int G, int bx) {
    const int wid = threadIdx.x >> 6, lane = threadIdx.x & 63;
    const long total = (long)MQ * 6;
    for (long wi = (long)bx * 8 + wid; wi < total; wi += (long)G * 8) {
        const int row = (int)(wi / 6), slot = (int)(wi - (long)row * 6);
        const int b = row / LT, t = row - b * LT;
        const bool isctx = t >= LSEQ;
        if (isctx && slot < 4) continue;
        const int col0 = slot < 4 ? slot * 128 : 1024 + (slot - 4) * 128;
        const float* gw = slot < 4 ? qg : kg;
        unsigned* p = (unsigned*)(QKV + (size_t)row * NIN + col0) + lane;
        const unsigned raw = *p;
        float x0 = bf2f(raw & 0xffffu), x1 = bf2f(raw >> 16);
        const float ss = wave_sum(x0 * x0 + x1 * x1);
        const float rstd = rsqrtf(ss * (1.f / 128.f) + EPS);
        x0 = x0 * rstd * gw[2 * lane]; x1 = x1 * rstd * gw[2 * lane + 1];
        if (!isctx) {
            const int pos = lane < 32 ? (t >> 6) : (t & 63);
            const float2 cs = rope[pos * 32 + (lane & 31)];
            const float y0 = x0 * cs.x - x1 * cs.y, y1 = x0 * cs.y + x1 * cs.x; x0 = y0; x1 = y1;
        }
        *p = pk2(x0, x1);
    }
}

constexpr int NA_VPITCH = 144, NA_VBUF = 32 * NA_VPITCH;
constexpr int NA_MOFF = 8 * NA_VBUF;
__device__ __forceinline__ void na_item(const bf16_t* __restrict__ QKV, const float* __restrict__ rpb, bf16_t* __restrict__ MIX, int b, int hb, int r, LAS unsigned char* lds) {
    const int tid = threadIdx.x, wid = __builtin_amdgcn_readfirstlane(tid >> 6), lane = tid & 63, n = lane & 15, kq = lane >> 4;
    const int qg = wid & 3, kh = wid >> 2;
    const int c0 = qg * 16, kc0 = (qg == 0) ? 0 : (qg == 1) ? 8 : (qg == 2) ? 24 : 32;
    const int r0 = min(max(r - 4, 0), 56);
    const bf16_t* base = QKV + (size_t)b * LT * NIN;
    const bf16_t* qp = base + (size_t)(r * 64 + c0 + n) * NIN + 512 + hb * 64 + 8 * kq;
    const bf16x8 qf0 = *(const bf16x8*)qp, qf1 = *(const bf16x8*)(qp + 32);
    f32x4 s[16];
#pragma unroll
    for (int kb = 0; kb < 16; ++kb) {
        const int tok = kh == 0 ? ((r0 + (kb >> 1)) * 64 + kc0 + 16 * (kb & 1) + n) : (LSEQ + 16 * kb + n);
        const bf16_t* kp = base + (size_t)tok * NIN + 1536 + hb * 64 + 8 * kq;
        const bf16x8 a0 = *(const bf16x8*)kp, a1 = *(const bf16x8*)(kp + 32);
        f32x4 acc = {0.f, 0.f, 0.f, 0.f};
        acc = __builtin_amdgcn_mfma_f32_16x16x32_bf16(a0, qf0, acc, 0, 0, 0);
        acc = __builtin_amdgcn_mfma_f32_16x16x32_bf16(a1, qf1, acc, 0, 0, 0);
        s[kb] = acc;
    }
    float mx = -1e30f;
    if (kh == 0) {
        const int c = c0 + n, cs = min(max(c - 8, 0), 48);
        const float* rp = rpb + hb * 15 * 31;
#pragma unroll
        for (int kb = 0; kb < 16; ++kb) { const int i = kb >> 1, ro = r0 + i - r + 7;
#pragma unroll
            for (int j = 0; j < 4; ++j) { const int kc = kc0 + 16 * (kb & 1) + 4 * kq + j; const bool valid = (kc >= cs) && (kc < cs + 16);
                const int co = min(max(kc - c + 15, 0), 30);
                const float bias = rp[ro * 31 + co];
                const float v = valid ? s[kb][j] * 0.125f + bias : -1e30f; s[kb][j] = v; mx = fmaxf(mx, v); } }
    } else {
#pragma unroll
        for (int kb = 0; kb < 16; ++kb)
#pragma unroll
            for (int j = 0; j < 4; ++j) { const float v = s[kb][j] * 0.125f; s[kb][j] = v; mx = fmaxf(mx, v); }
    }
    mx = fmaxf(mx, __shfl_xor(mx, 16)); mx = fmaxf(mx, __shfl_xor(mx, 32));
    float lsum = 0.f;
#pragma unroll
    for (int kb = 0; kb < 16; ++kb)
#pragma unroll
        for (int j = 0; j < 4; ++j) { const float p = __builtin_amdgcn_exp2f((s[kb][j] - mx) * 1.4426950408889634f); s[kb][j] = p; lsum += p; }
    lsum += __shfl_xor(lsum, 16); lsum += __shfl_xor(lsum, 32);
    f32x4 o[4];
#pragma unroll
    for (int d = 0; d < 4; ++d) o[d] = (f32x4){0.f, 0.f, 0.f, 0.f};
    LAS unsigned char* vbuf = lds + wid * NA_VBUF;
    const int vrow = lane >> 1, vhalf = lane & 1;
    const LAS unsigned char* trp = vbuf + (4 * kq + (n >> 2)) * NA_VPITCH + (n & 3) * 8;
#pragma unroll
    for (int t = 0; t < 8; ++t) {
        const int tok0 = kh == 0 ? ((r0 + t) * 64 + kc0) : (LSEQ + 32 * t);
        const bf16_t* vp = base + (size_t)(tok0 + vrow) * NIN + 2048 + hb * 64 + vhalf * 32;
        const u32x4 v0 = *(const u32x4*)vp, v1 = *(const u32x4*)(vp + 8), v2 = *(const u32x4*)(vp + 16), v3 = *(const u32x4*)(vp + 24);
        LAS u32x4* wp = (LAS u32x4*)(vbuf + vrow * NA_VPITCH + vhalf * 64);
        wp[0] = v0; wp[1] = v1; wp[2] = v2; wp[3] = v3;
        u32x4 bw; bw.x = cvt_pk_bf16(s[2 * t][0], s[2 * t][1]); bw.y = cvt_pk_bf16(s[2 * t][2], s[2 * t][3]); bw.z = cvt_pk_bf16(s[2 * t + 1][0], s[2 * t + 1][1]); bw.w = cvt_pk_bf16(s[2 * t + 1][2], s[2 * t + 1][3]);
        const bf16x8 bfr = __builtin_bit_cast(bf16x8, bw);
#pragma unroll
        for (int d = 0; d < 4; ++d) {
            const s16x4 lo = vtr(trp + d * 32), hi = vtr(trp + 16 * NA_VPITCH + d * 32);
            const bf16x8 afr = (bf16x8){lo[0], lo[1], lo[2], lo[3], hi[0], hi[1], hi[2], hi[3]};
            o[d] = __builtin_amdgcn_mfma_f32_16x16x32_bf16(afr, bfr, o[d], 0, 0, 0);
        }
    }
    LAS float* mb = (LAS float*)(lds + NA_MOFF) + (qg * 64 + lane) * 18;
    if (kh == 1) { mb[0] = mx; mb[1] = lsum;
#pragma unroll
        for (int d = 0; d < 4; ++d)
#pragma unroll
            for (int j = 0; j < 4; ++j) mb[2 + d * 4 + j] = o[d][j]; }
    __syncthreads();
    if (kh == 0) {
        const float m1 = mb[0], l1 = mb[1];
        const float m = fmaxf(mx, m1), e0 = __builtin_amdgcn_exp2f((mx - m) * 1.4426950408889634f), e1 = __builtin_amdgcn_exp2f((m1 - m) * 1.4426950408889634f);
        const float inv = 1.f / (lsum * e0 + l1 * e1);
        bf16_t* op = MIX + (size_t)(b * LSEQ + r * 64 + c0 + n) * DM + 512 + hb * 64 + 4 * kq;
#pragma unroll
        for (int d = 0; d < 4; ++d) { float y[4];
#pragma unroll
            for (int j = 0; j < 4; ++j) y[j] = (o[d][j] * e0 + mb[2 + d * 4 + j] * e1) * inv;
            u32x2 w; w.x = pk2(y[0], y[1]); w.y = pk2(y[2], y[3]);
            *(u32x2*)(op + d * 16) = w; }
    }
    __syncthreads();
}

__device__ __forceinline__ void attention_phase(const bf16_t* __restrict__ QKV, const float* __restrict__ rpb, bf16_t* __restrict__ MIX, unsigned char* lds_g, LAS unsigned char* lds, int G, int vcu) {
    if (SEC(4)) for (int it = vcu; it < 256; it += G) {
        const int combo = it >> 5, w = it & 31, b = combo >> 1, kvh = combo & 1, g = w >> 4, qb = w & 15, h = kvh * 2 + g;
        const bf16_t* base = QKV + (size_t)b * LT * NIN;
        att::attn_dense_body(base + (size_t)(qb * 256) * NIN + h * 128, base + 1024 + kvh * 128, base + 1280 + kvh * 128,
                             MIX + (size_t)(b * LSEQ + qb * 256) * DM + h * 128, LT, (char*)lds_g);
    }
    const int per = (2048 + G - 1) / G;
    if (SEC(5)) for (int it = vcu * per; it < min(2048, (vcu + 1) * per); ++it) {
        const int combo = it >> 6, r = it & 63, b = combo >> 3, hb = combo & 7;
        na_item(QKV, rpb, MIX, b, hb, r, lds);
    }
}

__device__ __forceinline__ void convgate_phase(const bf16_t* __restrict__ U, bf16_t* __restrict__ ACT, const float* __restrict__ cw, const float* __restrict__ cb, int chunk, int G, int bx) {
    constexpr int RCH = 8, NCV = FF / 8;
    const long total = (long)(CHROWS / RCH) * NCV;
    for (long idx = (long)bx * 512 + threadIdx.x; idx < total; idx += (long)G * 512) {
        const int cv = (int)(idx % NCV), rc = (int)(idx / NCV);
        const int c = cv * 8, np = (c >> 7) * 256 + (c & 127);
        const int t0 = rc * RCH;
        float wg[3][8], wv[3][8], bg[8], bv[8];
#pragma unroll
        for (int j = 0; j < 3; ++j)
#pragma unroll
            for (int e = 0; e < 8; ++e) { wg[j][e] = cw[j * NUP + c + e]; wv[j][e] = cw[j * NUP + FF + c + e]; }
#pragma unroll
        for (int e = 0; e < 8; ++e) { bg[e] = cb[c + e]; bv[e] = cb[FF + c + e]; }
        float pg[8], pv[8], cg_[8], cv_[8], ng[8], nv[8];
        auto ld = [&](int t, float* g8, float* v8) {
            if (t < 0 || t >= CHROWS || ((t >> 12) != (t0 >> 12))) {
#pragma unroll
                for (int e = 0; e < 8; ++e) { g8[e] = 0.f; v8[e] = 0.f; }
            } else {
                const u32x4 a = *(const u32x4*)(U + (size_t)t * NUP + np), bq = *(const u32x4*)(U + (size_t)t * NUP + np + 128);
#pragma unroll
                for (int e = 0; e < 4; ++e) { g8[2 * e] = bf2f(a[e] & 0xffffu); g8[2 * e + 1] = bf2f(a[e] >> 16); v8[2 * e] = bf2f(bq[e] & 0xffffu); v8[2 * e + 1] = bf2f(bq[e] >> 16); }
            }
        };
        ld(t0 - 1, pg, pv); ld(t0, cg_, cv_);
#pragma unroll
        for (int i = 0; i < RCH; ++i) {
            ld(t0 + i + 1, ng, nv);
            float y[8];
#pragma unroll
            for (int e = 0; e < 8; ++e) {
                const float gg = pg[e] * wg[0][e] + cg_[e] * wg[1][e] + ng[e] * wg[2][e] + bg[e];
                const float vv = pv[e] * wv[0][e] + cv_[e] * wv[1][e] + nv[e] * wv[2][e] + bv[e];
                y[e] = gg / (1.f + __expf(-gg)) * vv;
            }
            u32x4 w; w.x = pk2(y[0], y[1]); w.y = pk2(y[2], y[3]); w.z = pk2(y[4], y[5]); w.w = pk2(y[6], y[7]);
            *(u32x4*)(ACT + ((size_t)chunk * CHROWS + t0 + i) * FF + c) = w;
#pragma unroll
            for (int e = 0; e < 8; ++e) { pg[e] = cg_[e]; pv[e] = cv_[e]; cg_[e] = ng[e]; cv_[e] = nv[e]; }
        }
    }
}

template <int STAGE>
__device__ __forceinline__ void fft_phase(const bf16_t* __restrict__ IN, bf16_t* __restrict__ OUT, const bf16_t* __restrict__ F, const float2* __restrict__ TW, LAS unsigned char* lds, int G, int bx) {
    constexpr int MB = STAGE == 1 ? 8 : 4, PITCH = 528;
    const int tid = threadIdx.x, wid = __builtin_amdgcn_readfirstlane(tid >> 6), lane = tid & 63, n = lane & 15, kq = lane >> 4;
    for (int it = bx; it < 1024; it += G) {
        const int g = it & 3, t = (it >> 2) & 63, b = it >> 8;
#pragma unroll
        for (int i = 0; i < 8; ++i) { const int cid = tid + 512 * i, row = cid >> 5, cc = cid & 31, ri = row >> 6, tt = row & 63;
            const size_t srow = STAGE == 1 ? ((size_t)b * 4096 + tt * 64 + t) : (((size_t)b * 64 + t) * 64 + tt);
            const u32x4 v = *(const u32x4*)(IN + srow * 2048 + g * 512 + ri * 256 + cc * 8);
            *(LAS u32x4*)(lds + row * PITCH + cc * 16) = v; }
        __syncthreads();
        f32x4 acc[MB][2];
#pragma unroll
        for (int mb = 0; mb < MB; ++mb) { acc[mb][0] = (f32x4){0.f, 0.f, 0.f, 0.f}; acc[mb][1] = (f32x4){0.f, 0.f, 0.f, 0.f}; }
#pragma unroll 1
        for (int ks = 0; ks < 4; ++ks) {
            bf16x8 bfr[2];
#pragma unroll
            for (int j = 0; j < 2; ++j) { const int nb = 2 * wid + j;
                const LAS unsigned char* p = lds + (ks * 32 + 8 * kq + (n >> 2)) * PITCH + (nb * 16 + 4 * (n & 3)) * 2;
                const s16x4 lo = vtr(p), hi = vtr(p + 4 * PITCH);
                bfr[j] = (bf16x8){lo[0], lo[1], lo[2], lo[3], hi[0], hi[1], hi[2], hi[3]}; }
#pragma unroll
            for (int mb = 0; mb < MB; ++mb) { const bf16x8 afr = *(const bf16x8*)(F + (mb * 16 + n) * 128 + ks * 32 + 8 * kq);
                acc[mb][0] = __builtin_amdgcn_mfma_f32_16x16x32_bf16(afr, bfr[0], acc[mb][0], 0, 0, 0);
                acc[mb][1] = __builtin_amdgcn_mfma_f32_16x16x32_bf16(afr, bfr[1], acc[mb][1], 0, 0, 0); }
        }
        if constexpr (STAGE == 1) {
#pragma unroll
            for (int mb = 0; mb < 4; ++mb)
#pragma unroll
                for (int jj = 0; jj < 4; ++jj) { const int k1 = mb * 16 + 4 * kq + jj; const float2 cs = TW[k1 * t];
                    bf16_t* orow = OUT + (((size_t)b * 64 + k1) * 64 + t) * 2048 + g * 512;
#pragma unroll
                    for (int j = 0; j < 2; ++j) { const float re = acc[mb][j][jj], im = acc[mb + 4][j][jj]; const int col = (2 * wid + j) * 16 + n;
                        orow[col] = (bf16_t)f2bf(re * cs.x + im * cs.y); orow[256 + col] = (bf16_t)f2bf(im * cs.x - re * cs.y); } }
        } else {
#pragma unroll
            for (int mb = 0; mb < 4; ++mb)
#pragma unroll
                for (int jj = 0; jj < 4; ++jj) { const int k2 = mb * 16 + 4 * kq + jj;
                    bf16_t* orow = OUT + ((size_t)b * 4096 + t + 64 * k2) * 1024 + g * 256;
#pragma unroll
                    for (int j = 0; j < 2; ++j) orow[(2 * wid + j) * 16 + n] = (bf16_t)f2bf(acc[mb][j][jj] * (1.f / 1024.f)); }
        }
        __syncthreads();
    }
}

#define FFN_CHUNK(l, ch) \
    if (RUN) { pg8::Gemm g{H + (size_t)(ch) * CHROWS * DM, (const bf16_t*)(ws + WS_WUP) + (size_t)(l) * NUP * DM, DM, DM, DM, 30}; pg8::StaticOrder S; S.init(CHROWS, NUP, G, bx); pg8::EpiStore E{U, NUP}; if (SEC(2)) pg8::gemm_phase(lds, g, S, E); } \
    SEAM(); \
    if (SEC(8) && RUN) convgate_phase(U, ACT, a.in[I_CW] + (size_t)(l) * 3 * NUP, a.in[I_CB] + (size_t)(l) * NUP, ch, G, bx); \
    SEAM();
#define FFN_LAYER(l) \
    if (SEC(1) && RUN) norm_mod_phase(a.out, nullptr, false, a.in[I_N2G] + (l) * DM, MOD + (size_t)(l) * 5 * 6144, 3, H, G, bx); \
    SEAM(); \
    FFN_CHUNK(l, 0) FFN_CHUNK(l, 1) \
    if (RUN) { pg8::Gemm g{ACT, (const bf16_t*)(ws + WS_WDN) + (size_t)(l) * DM * FF, FF, FF, FF, 30}; pg8::StaticOrder S; S.init(ML, DM, G, bx); pg8::EpiResid E{a.out, a.out, MOD + (size_t)(l) * 5 * 6144 + 5 * 1024}; if (SEC(6)) pg8::gemm_phase(lds, g, S, E); } \
    SEAM();
static_assert(NCH == 2, "FFN_LAYER expands two chunks");
constexpr int NPH = 10 + 4 * NCH + 10;
__global__ void __launch_bounds__(512, 2) fwd_kernel(Args a) {
    extern __shared__ __attribute__((aligned(16))) unsigned char lds_g[];
    LAS unsigned char* lds = (LAS unsigned char*)lds_g;
    const int G = gridDim.x, bx = blockIdx.x;
    const int vcu = (G % 8 == 0) ? (bx % 8) * (G / 8) + bx / 8 : bx;
    unsigned char* ws = a.ws;
    bf16_t* H = (bf16_t*)(ws + WS_H); bf16_t* QKV = (bf16_t*)(ws + WS_QKV); bf16_t* MIX = (bf16_t*)(ws + WS_MIX);
    bf16_t* U = (bf16_t*)(ws + WS_U); bf16_t* ACT = (bf16_t*)(ws + WS_ACT);
    bf16_t* Z = (bf16_t*)(ws + WS_Z); bf16_t* A1 = (bf16_t*)(ws + WS_A1); bf16_t* Y = (bf16_t*)(ws + WS_Y);
    float* MOD = (float*)(ws + WS_MOD);
    const int lo = a.ph_lo, hi = a.ph_hi;
    int ph = 0;
    volatile LAS unsigned* xst = (volatile LAS unsigned*)(lds + LDS_BYTES - 16);
    if (threadIdx.x == 0) { xst[0] = 0u; xst[1] = 0u; }
    __syncthreads();
    const XcdBarrier xbar = xcd_barrier_post((unsigned*)(ws + WS_BAR), xst);
    if (hi < 0) cg::this_grid().sync();
#if MK_SPLIT
#define SEAM() do { ++ph; } while (0)
#else
#define SEAM() do { if (lo <= ph && ph + 1 < hi) xcd_barrier(xbar); ++ph; } while (0)
#endif
#define RUN (lo <= ph && ph < hi)


    if (SEC(0) && RUN) p0_prologue(a, lds, G, bx);
    SEAM();
    if (SEC(1) && RUN) norm_mod_phase(a.in[I_X], a.in[I_CTX], true, a.in[I_N1G], MOD, 0, H, G, bx);
    SEAM();
    if (RUN) { pg8::Gemm g{H, (const bf16_t*)(ws + WS_WIN), DM, DM, DM, 30}; pg8::StaticOrder S; S.init(MQ, NIN, G, bx); pg8::EpiStore E{QKV, NIN}; if (SEC(2)) pg8::gemm_phase(lds, g, S, E); }
    SEAM();
    if (SEC(3) && RUN) qknorm_phase(QKV, a.in[I_QG], a.in[I_KG], (const float2*)(ws + WS_ROPE), G, bx);
    SEAM();
    if ((SEC(4) || SEC(5)) && RUN) attention_phase(QKV, a.in[I_RPB], MIX, lds_g, lds, G, vcu);
    SEAM();
    if (RUN) { pg8::Gemm g{MIX, (const bf16_t*)(ws + WS_WO), DM, DM, DM, 30}; pg8::StaticOrder S; S.init(ML, DM, G, bx); pg8::EpiResid E{a.in[I_X], a.out, MOD + 2048}; if (SEC(6)) pg8::gemm_phase(lds, g, S, E); }
    SEAM();
    FFN_LAYER(0);
    if (SEC(1) && RUN) norm_mod_phase(a.out, nullptr, false, a.in[I_N1G] + DM, MOD + 5 * 6144, 0, H, G, bx);
    SEAM();
    if (RUN) { pg8::Gemm g{H, (const bf16_t*)(ws + WS_DFTC), DM, 256, 256, 1}; pg8::StaticOrder S; S.init(ML, 2048, G, bx); pg8::EpiStore E{Z, 2048}; if (SEC(2)) pg8::gemm_phase(lds, g, S, E); }
    SEAM();
    if (SEC(7) && RUN) fft_phase<1>(Z, A1, (const bf16_t*)(ws + WS_F1), (const float2*)(ws + WS_TW), lds, G, bx);
    SEAM();
    if (SEC(7) && RUN) fft_phase<2>(A1, Y, (const bf16_t*)(ws + WS_F2), (const float2*)(ws + WS_TW), lds, G, bx);
    SEAM();
    if (RUN) { pg8::Gemm g{Y, (const bf16_t*)(ws + WS_WF), DM, DM, DM, 30}; pg8::StaticOrder S; S.init(ML, DM, G, bx); pg8::EpiResid E{a.out, a.out, MOD + 5 * 6144 + 2048}; if (SEC(6)) pg8::gemm_phase(lds, g, S, E); }
    SEAM();
    FFN_LAYER(1);
    if (SEC(9) && RUN) final_norm_phase(a.out, a.in[I_FG], G, bx);
#undef SEAM
#undef RUN
}

extern "C" void kernel_launch(void* const* d_in, const int* in_sizes, int n_in, void* d_out, int out_size, void* d_ws, size_t ws_size, hipStream_t stream) {
    static int grid = 0;
    if (grid == 0) {
        if (n_in != 19 || in_sizes[0] != ML * DM || out_size != ML * DM || ws_size < WS_END) { fprintf(stderr, "kernel_launch: unexpected shapes (n_in %d, in0 %d, out %d, ws %zu < %zu)\n", n_in, n_in > 0 ? in_sizes[0] : -1, out_size, ws_size, (size_t)WS_END); grid = -1; return; }
        int dev = 0, cus = 0, per_cu = 0;
        hipGetDevice(&dev);
        hipDeviceGetAttribute(&cus, hipDeviceAttributeMultiprocessorCount, dev);
        if (hipFuncSetAttribute((const void*)fwd_kernel, hipFuncAttributeMaxDynamicSharedMemorySize, LDS_BYTES) != hipSuccess) { fprintf(stderr, "kernel_launch: hipFuncSetAttribute failed\n"); grid = -1; return; }
        if (hipOccupancyMaxActiveBlocksPerMultiprocessor(&per_cu, (const void*)fwd_kernel, 512, LDS_BYTES) != hipSuccess || per_cu < 1) { fprintf(stderr, "kernel_launch: occupancy query says %d\n", per_cu); per_cu = 1; }
        (void)hipGetLastError();
        grid = cus * (per_cu > 1 ? 1 : per_cu);
        if (grid <= 0) grid = 256;
    }
    if (grid < 0) return;
    Args a{};
    for (int i = 0; i < 19; ++i) a.in[i] = (const float*)d_in[i];
    a.out = (float*)d_out; a.ws = (unsigned char*)d_ws;
#if MK_SPLIT
    for (int p = 0; p < NPH + 2; ++p) { a.ph_lo = p; a.ph_hi = p + 1; hipLaunchKernelGGL(fwd_kernel, dim3(grid), dim3(512), LDS_BYTES, stream, a); }
#else
    a.ph_lo = 0; a.ph_hi = 1000;
    if (hipMemsetAsync((char*)d_ws + WS_BAR, 0, 16384, stream) != hipSuccess) { fprintf(stderr, "kernel_launch: memset failed\n"); return; }
    void* args[] = {&a};
    hipError_t e = hipLaunchCooperativeKernel((const void*)fwd_kernel, dim3(grid), dim3(512), args, LDS_BYTES, stream);
    if (e != hipSuccess) fprintf(stderr, "kernel_launch: cooperative launch failed: %s (grid %d)\n", hipGetErrorString(e), grid);
#endif
}
```

```cpp
#include <hip/hip_runtime.h>
#include <hip/hip_cooperative_groups.h>
#include <cstdio>
#include <cstdint>
namespace cg = cooperative_groups;

#define LAS __attribute__((address_space(3)))
typedef unsigned short bf16_t;
typedef short bf16x8 __attribute__((ext_vector_type(8)));
typedef short s16x4 __attribute__((ext_vector_type(4)));
typedef short v4i16_t __attribute__((ext_vector_type(4)));
typedef float f32x4 __attribute__((ext_vector_type(4)));
typedef float f32x8 __attribute__((ext_vector_type(8)));
typedef float f32x16 __attribute__((ext_vector_type(16)));
typedef unsigned u32x4 __attribute__((ext_vector_type(4)));
typedef unsigned u32x2 __attribute__((ext_vector_type(2)));

#ifndef SECMASK
#define SECMASK 0xFFFF
#endif
#define SEC(k) ((SECMASK >> (k)) & 1)
#ifndef MK_SPLIT
#define MK_SPLIT 0
#endif

constexpr int NB = 4, LSEQ = 4096, CTXL = 256, LT = LSEQ + CTXL, MQ = NB * LT, ML = NB * LSEQ, DM = 1024, NIN = 2560, FF = 2816, NUP = 5632;
constexpr int NCH = 2, CHROWS = ML / NCH;
constexpr float EPS = 1e-6f;

constexpr size_t WS_WIN = 0;
constexpr size_t WS_WO = WS_WIN + (size_t)NIN * DM * 2;
constexpr size_t WS_WF = WS_WO + (size_t)DM * DM * 2;
constexpr size_t WS_WUP = WS_WF + (size_t)DM * DM * 2;
constexpr size_t WS_WDN = WS_WUP + 2 * (size_t)NUP * DM * 2;
constexpr size_t WS_DFTC = WS_WDN + 2 * (size_t)DM * FF * 2;
constexpr size_t WS_F1 = WS_DFTC + 512 * 256 * 2;
constexpr size_t WS_F2 = WS_F1 + 128 * 128 * 2;
constexpr size_t WS_TW = WS_F2 + 64 * 128 * 2;
constexpr size_t WS_ROPE = WS_TW + 4096 * 8;
constexpr size_t WS_BAR = WS_ROPE + 64 * 32 * 8;
constexpr size_t WS_MOD = WS_BAR + 16384;
constexpr size_t WS_H = WS_MOD + 2 * 5 * 6144 * 4 + (512 << 10);
constexpr size_t WS_R0 = WS_H + (size_t)MQ * DM * 2 + (512 << 10);
constexpr size_t WS_QKV = WS_R0, WS_MIX = WS_QKV + (size_t)MQ * NIN * 2;
constexpr size_t WS_ACT = WS_R0;
constexpr size_t WS_Z = WS_R0, WS_A1 = WS_Z + (size_t)ML * 2048 * 2, WS_Y = WS_A1 + (size_t)ML * 2048 * 2;
constexpr size_t WS_END0 = WS_ACT + (size_t)ML * FF * 2, WS_END1 = WS_Y + (size_t)ML * DM * 2, WS_END2 = WS_MIX + (size_t)ML * DM * 2;
constexpr size_t WS_END = WS_END0 > WS_END1 ? (WS_END0 > WS_END2 ? WS_END0 : WS_END2) : (WS_END1 > WS_END2 ? WS_END1 : WS_END2);
static_assert(WS_END <= 268435456ull, "workspace map exceeds 256 MiB");
static_assert(WS_H % 256 == 0 && WS_R0 % 256 == 0 && WS_MOD % 256 == 0, "alignment");

constexpr int LDS_BYTES = 147456;

__device__ __forceinline__ unsigned f2bf(float f) { unsigned u = __float_as_uint(f); return (u + 0x7fffu + ((u >> 16) & 1u)) >> 16; }
__device__ __forceinline__ unsigned pk2(float lo, float hi) { return f2bf(lo) | (f2bf(hi) << 16); }
__device__ __forceinline__ float bf2f(unsigned v) { return __uint_as_float(v << 16); }
__device__ __forceinline__ unsigned cvt_pk_bf16(float lo, float hi) { unsigned r; asm volatile("v_cvt_pk_bf16_f32 %0, %1, %2" : "=v"(r) : "v"(lo), "v"(hi)); return r; }
__device__ __forceinline__ float wave_sum(float v) {
#pragma unroll
    for (int o = 1; o < 64; o <<= 1) v += __shfl_xor(v, o);
    return v;
}

namespace pg8 {
constexpr int BM = 256, BK = 64, HALF = 128, HTB = HALF * BK * 2, STAGE_BYTES = 8 * HTB, NXCD = 8, WGM = 8;
__host__ __device__ __forceinline__ int lds_byte(int r, int c) { const int st = (r >> 4) * 2 + (c >> 5), rr = r & 15, cc = c & 31, ob = rr * 64 + cc * 2; return st * 1024 + (ob ^ (((ob >> 9) & 1) << 5)); }
__host__ __device__ __forceinline__ void stage_rc(int b, int& R, int& C) { const int st = b / 1024, sb = b % 1024, swz = sb ^ (((sb >> 9) & 1) << 5); R = (st >> 1) * 16 + swz / 64; C = (st & 1) * 32 + (swz % 64) / 2; }
__host__ __device__ __forceinline__ int perm32(int rho) { const int n = rho >> 4, i = rho & 15; return 8 * (i >> 2) + 4 * n + (i & 3); }

struct Unit { int pm, pn; };
struct Gemm { const bf16_t* A; const bf16_t* Bt; int lda, ldb, K, gs, mstep, moff; };

struct StaticOrder {
    int nM, nN, nwg, G, c;
    __host__ __device__ void init(int M, int N, int G_, int c_) { nM = M / BM; nN = N / BM; nwg = nM * nN; G = G_; c = c_; }
    __host__ __device__ void init_tiles(int nM_, int nN_, int G_, int c_) { nM = nM_; nN = nN_; nwg = nM * nN; G = G_; c = c_; }
    __host__ __device__ bool next(int i, Unit& u) const {
        const long L = (long)i * G + c; if (L >= nwg) return false;
        int wgid = (int)L; { const int q = nwg / NXCD, r = nwg % NXCD, xcd = wgid % NXCD, off = wgid / NXCD; wgid = (xcd < r ? xcd * (q + 1) : r * (q + 1) + (xcd - r) * q) + off; }
        const int nig = WGM * nN, gid = wgid / nig, fm = gid * WGM, gsz = (nM - fm) < WGM ? (nM - fm) : WGM;
        u.pm = fm + ((wgid % nig) % gsz); u.pn = (wgid % nig) / gsz; return true;
    }
};

struct EpiStore {
    static constexpr bool PERM = true;
    bf16_t* O; int ldc;
    __device__ __forceinline__ void operator()(const f32x4 (&acc)[2][2][4][2], const Unit& u, int wr, int wc, int fr, int fq, LAS unsigned char*) const {
        const int row0 = u.pm * BM + wr * 64 + fr, col0 = u.pn * BM + wc * 32 + 8 * fq;
#pragma unroll
        for (int ai = 0; ai < 2; ++ai)
#pragma unroll
            for (int m = 0; m < 4; ++m) { bf16_t* rowp = O + (size_t)(row0 + ai * HALF + m * 16) * ldc + col0;
#pragma unroll
                for (int bj = 0; bj < 2; ++bj) { const f32x4 v0 = acc[ai][bj][m][0], v1 = acc[ai][bj][m][1];
                    u32x4 w; w.x = cvt_pk_bf16(v0[0], v0[1]); w.y = cvt_pk_bf16(v0[2], v0[3]); w.z = cvt_pk_bf16(v1[0], v1[1]); w.w = cvt_pk_bf16(v1[2], v1[3]);
                    *(u32x4*)(rowp + bj * HALF) = w; } }
    }
};
struct EpiResid {
    static constexpr bool PERM = true;
    const float* R; float* O; const float* gate;
    __device__ __forceinline__ void operator()(const f32x4 (&acc)[2][2][4][2], const Unit& u, int wr, int wc, int fr, int fq, LAS unsigned char*) const {
        const int row0 = u.pm * BM + wr * 64 + fr, col0 = u.pn * BM + wc * 32 + 8 * fq;
        const float* gp = gate + (size_t)((u.pm * BM) >> 12) * 6144 + col0;
        f32x4 gv[2][2];
#pragma unroll
        for (int bj = 0; bj < 2; ++bj)
#pragma unroll
            for (int n = 0; n < 2; ++n) gv[bj][n] = *(const f32x4*)(gp + bj * HALF + 4 * n);
#pragma unroll
        for (int ai = 0; ai < 2; ++ai)
#pragma unroll
            for (int m = 0; m < 4; ++m) { const size_t ro = (size_t)(row0 + ai * HALF + m * 16) * DM + col0;
#pragma unroll
                for (int bj = 0; bj < 2; ++bj)
#pragma unroll
                    for (int n = 0; n < 2; ++n) { const size_t idx = ro + bj * HALF + 4 * n;
                        const f32x4 r = *(const f32x4*)(R + idx);
                        *(f32x4*)(O + idx) = r + gv[bj][n] * acc[ai][bj][m][n]; } }
    }
};

__device__ __forceinline__ float dppf(float old, float src, const int ctrl_sel) {
    const int o = __float_as_int(old), v = __float_as_int(src); int r;
    if (ctrl_sel == 0) r = __builtin_amdgcn_update_dpp(o, v, 0x111, 0xf, 0xf, false);
    else if (ctrl_sel == 1) r = __builtin_amdgcn_update_dpp(o, v, 0x101, 0xf, 0xf, false);
    else if (ctrl_sel == 2) r = __builtin_amdgcn_update_dpp(o, v, 0x121, 0xf, 0xf, false);
    else r = __builtin_amdgcn_update_dpp(o, v, 0x12F, 0xf, 0xf, false);
    return __int_as_float(r);
}
struct EpiConvGate {
    static constexpr bool PERM = true;
    bf16_t* ACT; const float* cw; const float* cb;
    __device__ __forceinline__ void operator()(const f32x4 (&acc)[2][2][4][2], const Unit& u, int wr, int wc, int fr, int fq, LAS unsigned char* xl) const {
        LAS float* X = (LAS float*)xl;
#define XIDX(w_r, a_i, e_d, b_j) ((((((w_r) * 4 + wc) * 2 + (a_i)) * 2 + (e_d)) * 2 + (b_j)) * 32 + 8 * fq)
        if (fr == 0) {
#pragma unroll
            for (int ai = 0; ai < 2; ++ai)
#pragma unroll
                for (int bj = 0; bj < 2; ++bj)
#pragma unroll
                    for (int n = 0; n < 2; ++n) *(LAS f32x4*)&X[XIDX(wr, ai, 0, bj) + 4 * n] = acc[ai][bj][0][n];
        }
        if (fr == 15) {
#pragma unroll
            for (int ai = 0; ai < 2; ++ai)
#pragma unroll
                for (int bj = 0; bj < 2; ++bj)
#pragma unroll
                    for (int n = 0; n < 2; ++n) *(LAS f32x4*)&X[XIDX(wr, ai, 1, bj) + 4 * n] = acc[ai][bj][3][n];
        }
        asm volatile("s_waitcnt lgkmcnt(0)" ::: "memory");
        __builtin_amdgcn_s_barrier();
        const int grow0 = u.pm * 254 - 1;
#pragma unroll
        for (int n = 0; n < 2; ++n) {
            const int col = u.pn * 128 + wc * 32 + 8 * fq + 4 * n;
            const f32x4 wg0 = *(const f32x4*)(cw + col), wg1 = *(const f32x4*)(cw + NUP + col), wg2 = *(const f32x4*)(cw + 2 * NUP + col), bg = *(const f32x4*)(cb + col);
            const f32x4 wv0 = *(const f32x4*)(cw + FF + col), wv1 = *(const f32x4*)(cw + NUP + FF + col), wv2 = *(const f32x4*)(cw + 2 * NUP + FF + col), bv = *(const f32x4*)(cb + FF + col);
#pragma unroll
            for (int ai = 0; ai < 2; ++ai) {
                f32x4 ep[2], en[2];
#pragma unroll
                for (int bj = 0; bj < 2; ++bj) {
                    if (wr == 1) ep[bj] = *(LAS f32x4*)&X[XIDX(0, ai, 1, bj) + 4 * n];
                    else if (ai == 1) ep[bj] = *(LAS f32x4*)&X[XIDX(1, 0, 1, bj) + 4 * n];
                    else ep[bj] = (f32x4){0.f, 0.f, 0.f, 0.f};
                    if (wr == 0) en[bj] = *(LAS f32x4*)&X[XIDX(1, ai, 0, bj) + 4 * n];
                    else if (ai == 0) en[bj] = *(LAS f32x4*)&X[XIDX(0, 1, 0, bj) + 4 * n];
                    else en[bj] = (f32x4){0.f, 0.f, 0.f, 0.f};
                }
#pragma unroll
                for (int m = 0; m < 4; ++m) {
                    const int r = ai * 128 + wr * 64 + m * 16 + fr, gr = grow0 + r;
                    const bool pz = (gr & 4095) == 0, nz = (gr & 4095) == 4095;
                    f32x4 pv[2], nv[2];
#pragma unroll
                    for (int bj = 0; bj < 2; ++bj)
#pragma unroll
                        for (int j = 0; j < 4; ++j) {
                            const float cur = acc[ai][bj][m][n][j];
                            const float pe = (m > 0) ? dppf(0.f, acc[ai][bj][m > 0 ? m - 1 : 0][n][j], 2) : ep[bj][j];
                            const float ne = (m < 3) ? dppf(0.f, acc[ai][bj][m < 3 ? m + 1 : 3][n][j], 3) : en[bj][j];
                            const float p = dppf(pe, cur, 0), q = dppf(ne, cur, 1);
                            pv[bj][j] = pz ? 0.f : p; nv[bj][j] = nz ? 0.f : q;
                        }
                    const f32x4 gg = pv[0] * wg0 + acc[ai][0][m][n] * wg1 + nv[0] * wg2 + bg;
                    const f32x4 vv = pv[1] * wv0 + acc[ai][1][m][n] * wv1 + nv[1] * wv2 + bv;
                    float y[4];
#pragma unroll
                    for (int j = 0; j < 4; ++j) y[j] = gg[j] * __builtin_amdgcn_rcpf(1.f + __expf(-gg[j])) * vv[j];
                    if (r >= 1 && r <= 254 && gr < ML) {
                        u32x2 w; w.x = cvt_pk_bf16(y[0], y[1]); w.y = cvt_pk_bf16(y[2], y[3]);
                        *(u32x2*)(ACT + (size_t)gr * FF + col) = w;
                    }
                }
            }
        }
#undef XIDX
    }
};

template <class Epi>
__device__ __forceinline__ void gemm_phase(LAS unsigned char* lds, const Gemm g, const StaticOrder& S, const Epi& E) {
    const int tid = threadIdx.x, wid = __builtin_amdgcn_readfirstlane(tid >> 6), lane = tid & 63, wr = wid >> 2, wc = wid & 3, fr = lane & 15, fq = lane >> 4;
    const int K = g.K, nt = K / BK;
    unsigned voffA[2], voffB[2];
#pragma unroll
    for (int i = 0; i < 2; ++i) { int R, C; stage_rc(tid * 16 + i * 8192, R, C); const int Rb = Epi::PERM ? ((R & ~31) + perm32(R & 31)) : R;
        voffA[i] = (unsigned)(R * g.lda + C) * 2u; voffB[i] = (unsigned)(Rb * g.ldb + C) * 2u; }
    const size_t kstep = (size_t)(BK * 2);
    const size_t hstepA = (size_t)HALF * g.lda * 2, hstepB = (size_t)HALF * g.ldb * 2;
    const unsigned ldsw = (unsigned)wid * 1024u;
    const int aoff = lds_byte(wr * 64 + fr, fq * 8), boff = lds_byte(wc * 32 + fr, fq * 8);
    const int gmask = (1 << g.gs) - 1;
#define PG8_APTR(u) ((const char*)g.A + ((long)(u).pm * g.mstep + g.moff) * (long)g.lda * 2 + (size_t)((u).pn >> g.gs) * (size_t)K * 2)
#define PG8_BPTR(u) ((const char*)g.Bt + (size_t)((u).pn & gmask) * 2 * hstepB)
#define PG8_SA(b, h) (((b) * 2 + (h)) * HTB)
#define PG8_SB(b, h) ((4 + (b) * 2 + (h)) * HTB)
#define PG8_STAGE(bufoff, gbase, voff) do { _Pragma("unroll") for (int _i = 0; _i < 2; ++_i) \
        __builtin_amdgcn_global_load_lds((const unsigned*)((const char*)(gbase) + (voff)[_i]), (LAS unsigned*)(lds + (bufoff) + ldsw + _i * 8192), 16, 0, 0); } while (0)
#define PG8_LDA(dst, b, h) do { _Pragma("unroll") for (int m = 0; m < 4; ++m) _Pragma("unroll") for (int k = 0; k < 2; ++k) dst[m][k] = *(const LAS bf16x8*)(lds + PG8_SA(b, h) + aoff + m * 2048 + k * 1024); } while (0)
#define PG8_LDB(dst, b, h) do { _Pragma("unroll") for (int n = 0; n < 2; ++n) _Pragma("unroll") for (int k = 0; k < 2; ++k) dst[n][k] = *(const LAS bf16x8*)(lds + PG8_SB(b, h) + boff + n * 2048 + k * 1024); } while (0)
#define PG8_MMA(ai, bj, At, Bt) do { __builtin_amdgcn_s_setprio(1); _Pragma("unroll") for (int m = 0; m < 4; ++m) _Pragma("unroll") for (int n = 0; n < 2; ++n) _Pragma("unroll") for (int k = 0; k < 2; ++k) \
        acc[ai][bj][m][n] = __builtin_amdgcn_mfma_f32_16x16x32_bf16(Bt[n][k], At[m][k], acc[ai][bj][m][n], 0, 0, 0); __builtin_amdgcn_s_setprio(0); } while (0)
#define PG8_WAIT_V(n) asm volatile("s_waitcnt vmcnt(" #n ")" ::: "memory")
#define PG8_WAIT_L(n) asm volatile("s_waitcnt lgkmcnt(" #n ")" ::: "memory")
#define PG8_BAR __builtin_amdgcn_s_barrier()
#define PG8_SCHED __builtin_amdgcn_sched_barrier(0)
    Unit cur, nxt; int ui = 0;
    if (!S.next(0, cur)) return;
    f32x4 acc[2][2][4][2];
#pragma unroll
    for (int a = 0; a < 2; ++a)
#pragma unroll
        for (int b = 0; b < 2; ++b)
#pragma unroll
            for (int m = 0; m < 4; ++m)
#pragma unroll
                for (int n = 0; n < 2; ++n) acc[a][b][m][n] = (f32x4){0.f, 0.f, 0.f, 0.f};
    bf16x8 At[4][2], B0[2][2], B1[2][2];
    const char* cA = PG8_APTR(cur); const char* cB = PG8_BPTR(cur);
    PG8_STAGE(PG8_SB(0, 0), cB, voffB); PG8_STAGE(PG8_SB(0, 1), cB + hstepB, voffB); PG8_STAGE(PG8_SA(0, 0), cA, voffA); PG8_STAGE(PG8_SA(0, 1), cA + hstepA, voffA);
    if (wr == 1) PG8_BAR;
    PG8_WAIT_V(2); PG8_BAR;
    PG8_STAGE(PG8_SB(1, 0), cB + kstep, voffB); PG8_STAGE(PG8_SA(1, 0), cA + kstep, voffA); PG8_STAGE(PG8_SB(1, 1), cB + hstepB + kstep, voffB);
    PG8_WAIT_V(6); PG8_BAR;
    for (;;) {
        const bool has_next = S.next(ui + 1, nxt);
        const char* nA = has_next ? PG8_APTR(nxt) : cA; const char* nB = has_next ? PG8_BPTR(nxt) : cB;
        for (int t = 0; t < nt; t += 2) {
            const bool last = (t == nt - 2);
            const char* a1 = cA + (size_t)(t + 1) * kstep;
            const char* a2 = last ? nA : cA + (size_t)(t + 2) * kstep; const char* b2 = last ? nB : cB + (size_t)(t + 2) * kstep;
            const char* a3 = a2 + kstep; const char* b3 = b2 + kstep;
            PG8_LDB(B0, 0, 0); PG8_LDB(B1, 0, 1); PG8_SCHED; PG8_LDA(At, 0, 0); PG8_STAGE(PG8_SA(1, 1), a1 + hstepA, voffA);
            PG8_WAIT_V(8); PG8_WAIT_L(0); PG8_BAR; PG8_MMA(0, 0, At, B0); PG8_MMA(0, 1, At, B1); PG8_BAR; PG8_SCHED;
            PG8_LDA(At, 0, 1); PG8_STAGE(PG8_SB(0, 0), b2, voffB); PG8_STAGE(PG8_SB(0, 1), b2 + hstepB, voffB); PG8_STAGE(PG8_SA(0, 0), a2, voffA);
            PG8_WAIT_V(8); PG8_WAIT_L(0); PG8_BAR; PG8_MMA(1, 0, At, B0); PG8_MMA(1, 1, At, B1); PG8_BAR; PG8_SCHED;
            PG8_LDB(B0, 1, 0); PG8_LDB(B1, 1, 1); PG8_SCHED; PG8_LDA(At, 1, 0); PG8_STAGE(PG8_SA(0, 1), a2 + hstepA, voffA);
            PG8_WAIT_V(8); PG8_WAIT_L(0); PG8_BAR; PG8_MMA(0, 0, At, B0); PG8_MMA(0, 1, At, B1); PG8_BAR; PG8_SCHED;
            PG8_LDA(At, 1, 1); PG8_STAGE(PG8_SB(1, 0), b3, voffB); PG8_STAGE(PG8_SB(1, 1), b3 + hstepB, voffB); PG8_STAGE(PG8_SA(1, 0), a3, voffA);
            PG8_WAIT_V(8); PG8_WAIT_L(0); PG8_BAR; PG8_MMA(1, 0, At, B0); PG8_MMA(1, 1, At, B1); PG8_BAR; PG8_SCHED;
        }
        if (wr == 0) PG8_BAR;
        E(acc, cur, wr, wc, fr, fq, lds + STAGE_BYTES);
        if (!has_next) break;
#pragma unroll
        for (int a = 0; a < 2; ++a)
#pragma unroll
            for (int b = 0; b < 2; ++b)
#pragma unroll
                for (int m = 0; m < 4; ++m)
#pragma unroll
                    for (int n = 0; n < 2; ++n) acc[a][b][m][n] = (f32x4){0.f, 0.f, 0.f, 0.f};
        cur = nxt; cA = nA; cB = nB; ++ui;
        if (wr == 1) PG8_BAR;
    }
    PG8_WAIT_V(0);
    PG8_BAR;
#undef PG8_APTR
#undef PG8_BPTR
#undef PG8_SA
#undef PG8_SB
#undef PG8_STAGE
#undef PG8_LDA
#undef PG8_LDB
#undef PG8_MMA
#undef PG8_WAIT_V
#undef PG8_WAIT_L
#undef PG8_BAR
#undef PG8_SCHED
}
}

namespace att {
constexpr int D = 128, NW = 8, QBLK = 32, KVBLK = 64;
constexpr float SCALE = 0.088388347648318440f;
constexpr float THR = 8.f;
constexpr int LDQ = NIN, LDK = NIN, LDO = DM;
constexpr size_t SHM_V = KVBLK * D * 2, SHM_K = KVBLK * D * 2, SHM_ATTN = 2 * SHM_V + 2 * SHM_K + NW * 64 * 4;
#define KSWZ(row, colB) ((row) * 256 + ((colB) ^ (((row) & 7) << 4)))
#define SBAR() __builtin_amdgcn_sched_barrier(0)
__device__ __forceinline__ int crow(int r, int hi) { return (r & 3) + 8 * (r >> 2) + 4 * hi; }
__device__ __forceinline__ unsigned cvtpk(float lo, float hi) { unsigned r; asm volatile("v_cvt_pk_bf16_f32 %0, %1, %2" : "=v"(r) : "v"(lo), "v"(hi)); return r; }

__device__ __forceinline__ void partialSM(f32x16& p0, f32x16& p1, float& m_reg, float& mn, float& alpha) {
  constexpr float C = SCALE * 1.4426950408889634f;
  float pmax = p0[0];
#pragma unroll
  for (int r = 1; r < 16; ++r) pmax = fmaxf(pmax, p0[r]);
#pragma unroll
  for (int r = 0; r < 16; ++r) pmax = fmaxf(pmax, p1[r]);
  { auto rr = __builtin_amdgcn_permlane32_swap(__float_as_uint(pmax), __float_as_uint(pmax), false, false);
    pmax = fmaxf(__uint_as_float(rr[0]), __uint_as_float(rr[1])); }
  if (__builtin_expect(__all(pmax - m_reg <= THR / SCALE), 1)) { mn = m_reg; alpha = 1.f; }
  else { mn = fmaxf(m_reg, pmax); alpha = __builtin_amdgcn_exp2f((m_reg - mn) * C); m_reg = mn; }
  float mnC = -mn * C;
#pragma unroll
  for (int r = 0; r < 16; ++r) p0[r] = fmaf(p0[r], C, mnC);
#pragma unroll
  for (int r = 0; r < 16; ++r) p1[r] = fmaf(p1[r], C, mnC);
#pragma unroll
  for (int r = 0; r < 16; ++r) p0[r] = __builtin_amdgcn_exp2f(p0[r]);
}
__device__ __forceinline__ void finishSM(f32x16& p0, f32x16& p1, float alpha, float& l_reg, bf16x8& pa0, bf16x8& pa1, bf16x8& pa2, bf16x8& pa3) {
#pragma unroll
  for (int r = 0; r < 16; ++r) p1[r] = __builtin_amdgcn_exp2f(p1[r]);
  float ps = 0;
#pragma unroll
  for (int r = 0; r < 16; ++r) ps += p0[r];
#pragma unroll
  for (int r = 0; r < 16; ++r) ps += p1[r];
  { auto rr = __builtin_amdgcn_permlane32_swap(__float_as_uint(ps), __float_as_uint(ps), false, false);
    ps = __uint_as_float(rr[0]) + __uint_as_float(rr[1]); }
  l_reg = l_reg * alpha + ps;
#define PK4(P, BASE, OUT) do { unsigned a0 = cvtpk(P[BASE + 0], P[BASE + 1]), a1 = cvtpk(P[BASE + 2], P[BASE + 3]);   \
    unsigned b0 = cvtpk(P[BASE + 4], P[BASE + 5]), b1 = cvtpk(P[BASE + 6], P[BASE + 7]);                              \
    auto r0 = __builtin_amdgcn_permlane32_swap(a0, b0, false, false); auto r1 = __builtin_amdgcn_permlane32_swap(a1, b1, false, false); \
    u32x4 w = {r0[0], r1[0], r0[1], r1[1]}; OUT = *reinterpret_cast<bf16x8*>(&w); } while (0)
  PK4(p0, 0, pa0); PK4(p0, 8, pa1); PK4(p1, 0, pa2); PK4(p1, 8, pa3);
#undef PK4
}
__device__ __forceinline__ void qkt(f32x16& p0, f32x16& p1, const bf16_t* Ks, const bf16x8* qr, int r32, int hi) {
  p0 = f32x16{}; p1 = f32x16{};
#pragma unroll
  for (int d0 = 0; d0 < 8; ++d0) { int cb = (d0 * 16 + hi * 8) * 2;
    bf16x8 b0 = *reinterpret_cast<const bf16x8*>((const char*)Ks + KSWZ(r32, cb));
    bf16x8 b1 = *reinterpret_cast<const bf16x8*>((const char*)Ks + KSWZ(32 + r32, cb));
    p0 = __builtin_amdgcn_mfma_f32_32x32x16_bf16(b0, qr[d0], p0, 0, 0, 0);
    p1 = __builtin_amdgcn_mfma_f32_32x32x16_bf16(b1, qr[d0], p1, 0, 0, 0); }
}
__device__ __forceinline__ int v_st(int k, int c) { const int kk = (k & ~0xC) | ((k & 4) << 1) | ((k & 8) >> 1); return ((kk >> 3) * 4 + (c >> 5)) * 512 + ((kk & 7) * 32 + (c & 31)) * 2; }
__device__ __forceinline__ int v_rd_base(int lane) { return ((lane & 3) << 3) | (((lane >> 2) & 3) << 6) | (((lane >> 4) & 1) << 5) | (((lane >> 5) & 1) << 8); }
constexpr int v_rd_off(int d0, int ks, int half) { return d0 * 512 + ks * 4096 + half * 2048; }
template <int OFF> __device__ __forceinline__ s16x4 tr_read(int vb) {
  s16x4 r; asm volatile("ds_read_b64_tr_b16 %0, %1 offset:%2" : "=&v"(r) : "v"(vb), "i"(OFF) : "memory"); return r;
}
template <int D0> __device__ __forceinline__ void pv_one(f32x16& od, int vb, bf16x8 pa0, bf16x8 pa1, bf16x8 pa2, bf16x8 pa3) {
  const s16x4 l0 = tr_read<v_rd_off(D0, 0, 0)>(vb), h0 = tr_read<v_rd_off(D0, 0, 1)>(vb), l1 = tr_read<v_rd_off(D0, 1, 0)>(vb), h1 = tr_read<v_rd_off(D0, 1, 1)>(vb);
  const s16x4 l2 = tr_read<v_rd_off(D0, 2, 0)>(vb), h2 = tr_read<v_rd_off(D0, 2, 1)>(vb), l3 = tr_read<v_rd_off(D0, 3, 0)>(vb), h3 = tr_read<v_rd_off(D0, 3, 1)>(vb);
  asm volatile("s_waitcnt lgkmcnt(0)" ::: "memory"); SBAR();
#define PK(L, H) (bf16x8){L[0], L[1], L[2], L[3], H[0], H[1], H[2], H[3]}
  od = __builtin_amdgcn_mfma_f32_32x32x16_bf16(pa0, PK(l0, h0), od, 0, 0, 0);
  od = __builtin_amdgcn_mfma_f32_32x32x16_bf16(pa1, PK(l1, h1), od, 0, 0, 0);
  od = __builtin_amdgcn_mfma_f32_32x32x16_bf16(pa2, PK(l2, h2), od, 0, 0, 0);
  od = __builtin_amdgcn_mfma_f32_32x32x16_bf16(pa3, PK(l3, h3), od, 0, 0, 0);
#undef PK
}
__device__ __forceinline__ void pv_d0(f32x16* o, int vb, bf16x8 pa0, bf16x8 pa1, bf16x8 pa2, bf16x8 pa3) {
  pv_one<0>(o[0], vb, pa0, pa1, pa2, pa3); pv_one<1>(o[1], vb, pa0, pa1, pa2, pa3); pv_one<2>(o[2], vb, pa0, pa1, pa2, pa3); pv_one<3>(o[3], vb, pa0, pa1, pa2, pa3);
}

__device__ __forceinline__ void attn_dense_body(const bf16_t* __restrict__ Qb, const bf16_t* __restrict__ Kh, const bf16_t* __restrict__ Vh,
                                                bf16_t* __restrict__ Ob, int seq, char* lds) {
  const int tid = threadIdx.x, wid = tid >> 6, lane = tid & 63, r32 = lane & 31, hi = lane >> 5;
  bf16_t* V_lds = (bf16_t*)lds; bf16_t* K_lds = (bf16_t*)(lds + 2 * SHM_V);
  float* ws = (float*)(lds + 2 * SHM_V + 2 * SHM_K) + wid * 64; float* li_l = ws; float* al_l = ws + 32;
  float m_reg = -1e30f, l_reg = 0; f32x16 o[4] = {}; bf16x8 qr[8];
  const bf16_t* Qw = Qb + (long)(wid * QBLK + r32) * LDQ + hi * 8;
#pragma unroll
  for (int d0 = 0; d0 < 8; ++d0) qr[d0] = *reinterpret_cast<const bf16x8*>(Qw + d0 * 16);
  const int sr = tid >> 4, sc = (tid & 15) * 8, vst0 = v_st(sr, sc), vst1 = v_st(32 + sr, sc);
  const int vb0 = (int)(uintptr_t)V_lds + v_rd_base(lane);
  struct { bf16x8 vs0, vs1, ks0, ks1; } sr_[2];
#define SLOAD(i, k0) do { sr_[i].vs0 = *reinterpret_cast<const bf16x8*>(&Vh[(long)((k0) + sr) * LDK + sc]); sr_[i].vs1 = *reinterpret_cast<const bf16x8*>(&Vh[(long)((k0) + 32 + sr) * LDK + sc]); \
    sr_[i].ks0 = *reinterpret_cast<const bf16x8*>(&Kh[(long)((k0) + sr) * LDK + sc]); sr_[i].ks1 = *reinterpret_cast<const bf16x8*>(&Kh[(long)((k0) + 32 + sr) * LDK + sc]); } while (0)
#define SWRITE(b, i) do { *(bf16x8*)((char*)V_lds + (b) * SHM_V + vst0) = sr_[i].vs0;          \
    *(bf16x8*)((char*)V_lds + (b) * SHM_V + vst1) = sr_[i].vs1; int kc = sc * 2;               \
    *(bf16x8*)((char*)K_lds + (b) * SHM_K + KSWZ(sr, kc)) = sr_[i].ks0;                       \
    *(bf16x8*)((char*)K_lds + (b) * SHM_K + KSWZ(32 + sr, kc)) = sr_[i].ks1; } while (0)
#define SWAIT() asm volatile("s_waitcnt vmcnt(4)" ::: "memory")
#define RESC(a) do { if (__any((a) < 1.f)) { if (hi == 0) al_l[r32] = (a); asm volatile("s_waitcnt lgkmcnt(0)" ::: "memory"); \
    _Pragma("unroll") for (int d = 0; d < 4; ++d) _Pragma("unroll") for (int r = 0; r < 16; ++r) o[d][r] *= al_l[crow(r, hi)]; } } while (0)
  f32x16 pA0, pA1, pB0, pB1; float mnA, mnB, alA, alB; bf16x8 pa0, pa1, pa2, pa3; const int NT = seq / KVBLK;
  constexpr int SE = 0, SO = 1;
  SLOAD(SE, 0); asm volatile("s_waitcnt vmcnt(0)" ::: "memory"); SWRITE(0, SE); __syncthreads();
  qkt(pA0, pA1, K_lds, qr, r32, hi); partialSM(pA0, pA1, m_reg, mnA, alA);
  SLOAD(SO, KVBLK); if (2 < NT) SLOAD(SE, 2 * KVBLK);
  SWAIT(); SWRITE(1, SO); __syncthreads();
  for (int j = 1; j + 1 < NT; j += 2) {
    SBAR(); qkt(pB0, pB1, (bf16_t*)((char*)K_lds + SHM_K), qr, r32, hi);
    finishSM(pA0, pA1, alA, l_reg, pa0, pa1, pa2, pa3); SBAR();
    SLOAD(SO, (j + 2) * KVBLK); SBAR();
    pv_d0(o, vb0, pa0, pa1, pa2, pa3); partialSM(pB0, pB1, m_reg, mnB, alB);
    __syncthreads(); SWAIT(); SWRITE(0, SE);
    RESC(alB); __syncthreads();
    SBAR(); qkt(pA0, pA1, K_lds, qr, r32, hi);
    finishSM(pB0, pB1, alB, l_reg, pa0, pa1, pa2, pa3); SBAR();
    if (j + 3 < NT) SLOAD(SE, (j + 3) * KVBLK); SBAR();
    pv_d0(o, vb0 + (int)SHM_V, pa0, pa1, pa2, pa3); partialSM(pA0, pA1, m_reg, mnA, alA);
    __syncthreads(); SWAIT(); SWRITE(1, SO);
    RESC(alA); __syncthreads();
  }
  SBAR(); qkt(pB0, pB1, (bf16_t*)((char*)K_lds + SHM_K), qr, r32, hi);
  finishSM(pA0, pA1, alA, l_reg, pa0, pa1, pa2, pa3); SBAR();
  pv_d0(o, vb0, pa0, pa1, pa2, pa3); partialSM(pB0, pB1, m_reg, mnB, alB);
  __syncthreads(); RESC(alB);
  finishSM(pB0, pB1, alB, l_reg, pa0, pa1, pa2, pa3); SBAR();
  pv_d0(o, vb0 + (int)SHM_V, pa0, pa1, pa2, pa3);
  if (hi == 0) li_l[r32] = l_reg; asm volatile("s_waitcnt lgkmcnt(0)" ::: "memory");
  float rli[16];
#pragma unroll
  for (int r = 0; r < 16; ++r) rli[r] = __builtin_amdgcn_rcpf(li_l[crow(r, hi)]);
  bf16_t* Ow = Ob + (long)(wid * QBLK) * LDO;
#pragma unroll
  for (int r = 0; r < 16; ++r) { int orow = crow(r, hi);
#pragma unroll
    for (int d0 = 0; d0 < 4; ++d0) Ow[(long)orow * LDO + d0 * 32 + r32] = (bf16_t)f2bf(o[d0][r] * rli[r]); }
  __syncthreads();
#undef SLOAD
#undef SWRITE
#undef SWAIT
#undef RESC
}
}

#define XB_TMO      128
#define XB_XCNT(j)  (256  + 64 * (j))
#define XB_XSUB(j)  (1280 + 64 * (j))
#define XB_XGEN(j)  (2304 + 64 * (j))
#define XB_TOP      3328
#define XB_TOPGEN   3392
#define XCD_BAR_WORDS 3456
#define XB_SPIN_CAP (1u << 18)
static_assert(XCD_BAR_WORDS * 4 <= 16384, "barrier words");
__device__ __forceinline__ unsigned xb_ld(unsigned* p)              { return __hip_atomic_load(p, __ATOMIC_RELAXED, __HIP_MEMORY_SCOPE_AGENT); }
__device__ __forceinline__ unsigned xb_add(unsigned* p, unsigned v) { return __hip_atomic_fetch_add(p, v, __ATOMIC_RELAXED, __HIP_MEMORY_SCOPE_AGENT); }
__device__ __forceinline__ unsigned xb_xcc_id() { return (unsigned)__builtin_amdgcn_s_getreg((3 << 11) | 20) & 0xFu; }
#define XB_SPIN(cond, bar) do { unsigned _sp = 0; while (cond) { __builtin_amdgcn_s_sleep(1); \
    if ((++_sp & 255u) == 0u) { if (xb_ld(&(bar)[XB_TMO])) break; if (_sp > XB_SPIN_CAP) { atomicAdd(&(bar)[XB_TMO], 1u); break; } } } } while (0)
struct XcdBarrier { unsigned* bar; unsigned x; volatile LAS unsigned* st; };
__device__ __forceinline__ XcdBarrier xcd_barrier_post(unsigned* bar, volatile LAS unsigned* st) {
    XcdBarrier b; b.bar = bar; b.x = xb_xcc_id(); b.st = st;
    if (threadIdx.x == 0) (void)xb_add(&bar[XB_XCNT(b.x)], 1u);
    return b;
}
__device__ __forceinline__ void xcd_barrier_complete(unsigned* bar, unsigned x, unsigned& nloc, unsigned& nx) {
    const unsigned G = gridDim.x * gridDim.y * gridDim.z;
    unsigned sum, cnt, mine, sp = 0u;
    for (;;) {
        sum = 0u; cnt = 0u; mine = 0u;
#pragma unroll
        for (unsigned j = 0; j < 16; ++j) { const unsigned c = xb_ld(&bar[XB_XCNT(j)]); sum += c; cnt += (c > 0u) ? 1u : 0u; mine = (j == x) ? c : mine; }
        if (sum == G) break;
        __builtin_amdgcn_s_sleep(1);
        if ((++sp & 255u) == 0u) { if (xb_ld(&bar[XB_TMO])) break; if (sp > XB_SPIN_CAP) { atomicAdd(&bar[XB_TMO], 1u); break; } }
    }
    nloc = mine > 0u ? mine : 1u; nx = cnt > 0u ? cnt : 1u;
}
__device__ __forceinline__ void xcd_barrier(const XcdBarrier& b) {
    asm volatile("s_waitcnt vmcnt(0)" ::: "memory");
    __syncthreads();
    if (threadIdx.x == 0) {
        unsigned* bar = b.bar;
        __builtin_amdgcn_s_waitcnt(0);
        unsigned nloc = b.st[0], nx = b.st[1];
        if (nloc == 0u) { xcd_barrier_complete(bar, b.x, nloc, nx); b.st[0] = nloc; b.st[1] = nx; }
        const unsigned old = xb_add(&bar[XB_XSUB(b.x)], 1u);
        const unsigned gen = old / nloc;
        if (old + 1u == (gen + 1u) * nloc) {
            __builtin_amdgcn_fence(__ATOMIC_RELEASE, "agent");
            asm volatile("s_waitcnt vmcnt(0)" ::: "memory");
            const unsigned og = xb_add(&bar[XB_TOP], 1u);
            const unsigned tg = og / nx;
            if (og + 1u == (tg + 1u) * nx) xb_add(&bar[XB_TOPGEN], 1u);
            else XB_SPIN(xb_ld(&bar[XB_TOPGEN]) == tg, bar);
            __builtin_amdgcn_fence(__ATOMIC_ACQUIRE, "agent");
            xb_add(&bar[XB_XGEN(b.x)], 1u);
            asm volatile("s_waitcnt vmcnt(0)" ::: "memory");
        } else {
            XB_SPIN(xb_ld(&bar[XB_XGEN(b.x)]) == gen, bar);
            __builtin_amdgcn_fence(__ATOMIC_ACQUIRE, "agent");
            asm volatile("s_waitcnt vmcnt(0)" ::: "memory");
        }
    }
    __syncthreads();
}

struct Args { const float* in[19]; float* out; unsigned char* ws; int ph_lo, ph_hi; };
enum { I_X = 0, I_C, I_CTX, I_CCTX, I_MODW, I_MODB, I_N1G, I_N2G, I_WIN, I_WOUT, I_QG, I_KG, I_RPB, I_FW, I_WUP, I_CW, I_CB, I_WDN, I_FG };

__device__ __forceinline__ s16x4 vtr(const LAS unsigned char* p) { return __builtin_bit_cast(s16x4, __builtin_amdgcn_ds_read_tr16_b64_v4i16((LAS v4i16_t*)p)); }

__device__ __forceinline__ int up_perm(int n) { return n < FF ? ((n >> 7) * 256 + (n & 127)) : ((((n - FF) >> 7) * 256) + 128 + ((n - FF) & 127)); }

__device__ __forceinline__ void transpose_tile(const float* __restrict__ W, int N, bf16_t* __restrict__ WT, int ldt, int tk, int tn, bool perm, LAS float* scr) {
    const int tid = threadIdx.x;
#pragma unroll
    for (int i = 0; i < 8; ++i) { const int kk = (tid >> 6) + 8 * i, nn = tid & 63; scr[kk * 65 + nn] = W[(size_t)(tk * 64 + kk) * N + tn * 64 + nn]; }
    __syncthreads();
    { const int nn = tid >> 3, kc = tid & 7; float v[8];
#pragma unroll
      for (int e = 0; e < 8; ++e) v[e] = scr[(kc * 8 + e) * 65 + nn];
      const int n = tn * 64 + nn, nrow = perm ? up_perm(n) : n;
      u32x4 w; w.x = pk2(v[0], v[1]); w.y = pk2(v[2], v[3]); w.z = pk2(v[4], v[5]); w.w = pk2(v[6], v[7]);
      *(u32x4*)(WT + (size_t)nrow * ldt + tk * 64 + kc * 8) = w; }
    __syncthreads();
}

__device__ __forceinline__ void adaln_item(const Args& a, int item, float* MOD, LAS float* sv, LAS float* red) {
    const int tid = threadIdx.x, l = item / 96, j = item % 96;
    const float* c = a.in[I_C]; const float* cc = a.in[I_CCTX];
    for (int idx = tid; idx < 5 * 1024; idx += 512) { const int r = idx >> 10, k = idx & 1023; const float v = r < 4 ? c[r * 1024 + k] : cc[k]; sv[idx] = v / (1.f + __expf(-v)); }
    __syncthreads();
    const int col = tid & 63, kg = tid >> 6;
    const float* w = a.in[I_MODW] + (size_t)l * 1024 * 6144 + j * 64 + col;
    float acc[5] = {0.f, 0.f, 0.f, 0.f, 0.f};
    for (int k = kg * 128; k < kg * 128 + 128; ++k) { const float wv = w[(size_t)k * 6144];
#pragma unroll
        for (int r = 0; r < 5; ++r) acc[r] += sv[r * 1024 + k] * wv; }
#pragma unroll
    for (int r = 0; r < 5; ++r) red[(kg * 5 + r) * 64 + col] = acc[r];
    __syncthreads();
    if (tid < 320) { const int r = tid >> 6, cl = tid & 63; float s = 0.f;
#pragma unroll
        for (int g = 0; g < 8; ++g) s += red[(g * 5 + r) * 64 + cl];
        MOD[(size_t)(l * 5 + r) * 6144 + j * 64 + cl] = s + a.in[I_MODB][l * 6144 + j * 64 + cl]; }
    __syncthreads();
}

__device__ __forceinline__ void p0_prologue(const Args& a, LAS unsigned char* lds, int G, int bx) {
    unsigned char* ws = a.ws;
    const int tid = threadIdx.x;
    {
        const long gt = (long)bx * 512 + tid, GT = (long)G * 512;
        bf16_t* dftc = (bf16_t*)(ws + WS_DFTC);
        for (long i = gt; i < 512 * 256; i += GT) { const int row = (int)(i >> 8), n = (int)(i & 255), ri = row >> 8, m = row & 255; float s, c; sincospif((float)((m * n) & 255) * (1.f / 128.f), &s, &c); dftc[i] = (bf16_t)f2bf(ri ? -s : c); }
        bf16_t* f1 = (bf16_t*)(ws + WS_F1);
        for (long i = gt; i < 128 * 128; i += GT) { const int row = (int)(i >> 7), col = (int)(i & 127), ro = row >> 6, k1 = row & 63, ri = col >> 6, t1 = col & 63; float s, c; sincospif((float)((k1 * t1) & 63) * (1.f / 32.f), &s, &c);
            const float v = (ro == 0) ? (ri == 0 ? c : s) : (ri == 0 ? -s : c); f1[i] = (bf16_t)f2bf(v); }
        bf16_t* f2 = (bf16_t*)(ws + WS_F2);
        for (long i = gt; i < 64 * 128; i += GT) { const int k2 = (int)(i >> 7), col = (int)(i & 127), ri = col >> 6, t2 = col & 63; float s, c; sincospif((float)((k2 * t2) & 63) * (1.f / 32.f), &s, &c); f2[i] = (bf16_t)f2bf(ri == 0 ? c : s); }
        float2* tw = (float2*)(ws + WS_TW);
        for (long i = gt; i < 4096; i += GT) { float s, c; sincospif((float)i * (1.f / 2048.f), &s, &c); tw[i] = make_float2(c, s); }
        float2* rope = (float2*)(ws + WS_ROPE);
        for (long i = gt; i < 64 * 32; i += GT) { const int pos = (int)(i >> 5), j = (int)(i & 31); const float fr = powf(10000.f, -(float)j / 32.f); const float ang = (float)pos * fr; rope[i] = make_float2(cosf(ang), sinf(ang)); }
    }
    LAS float* scr = (LAS float*)lds;
    for (int it = bx; it < 192; it += G) adaln_item(a, it, (float*)(ws + WS_MOD), scr, scr + 5 * 1024);
    for (int t = bx; t < 5376; t += G) {
        if (t < 640) transpose_tile(a.in[I_WIN], NIN, (bf16_t*)(ws + WS_WIN), DM, t / 40, t % 40, false, scr);
        else if (t < 896) { const int u = t - 640; transpose_tile(a.in[I_WOUT], DM, (bf16_t*)(ws + WS_WO), DM, u / 16, u % 16, false, scr); }
        else if (t < 1152) { const int u = t - 896; transpose_tile(a.in[I_FW], DM, (bf16_t*)(ws + WS_WF), DM, u / 16, u % 16, false, scr); }
        else if (t < 3968) { const int u = t - 1152, l = u / 1408, v = u % 1408; transpose_tile(a.in[I_WUP] + (size_t)l * DM * NUP, NUP, (bf16_t*)(ws + WS_WUP) + (size_t)l * NUP * DM, DM, v / 88, v % 88, true, scr); }
        else { const int u = t - 3968, l = u / 704, v = u % 704; transpose_tile(a.in[I_WDN] + (size_t)l * FF * DM, DM, (bf16_t*)(ws + WS_WDN) + (size_t)l * DM * FF, FF, v / 16, v % 16, false, scr); }
    }
}

__device__ __forceinline__ void norm_mod_phase(const float* __restrict__ xl, const float* __restrict__ xc, bool with_ctx, const float* __restrict__ gain,
                                               const float* __restrict__ MODl, int chunk, bf16_t* __restrict__ out, int G, int bx) {
    const int wid = threadIdx.x >> 6, lane = threadIdx.x & 63;
    const int nrows = with_ctx ? MQ : ML;
    for (int row = bx * 8 + wid; row < nrows; row += G * 8) {
        int b, t; if (with_ctx) { b = row / LT; t = row - b * LT; } else { b = row >> 12; t = row & 4095; }
        const float* src = (t < LSEQ) ? xl + ((size_t)b * LSEQ + t) * DM : xc + ((size_t)b * CTXL + (t - LSEQ)) * DM;
        const float* mrow = MODl + (size_t)((t < LSEQ) ? b : 4) * 6144 + chunk * 1024;
        f32x4 v[4]; float ss = 0.f;
#pragma unroll
        for (int j = 0; j < 4; ++j) { v[j] = *(const f32x4*)(src + j * 256 + lane * 4); ss += v[j][0] * v[j][0] + v[j][1] * v[j][1] + v[j][2] * v[j][2] + v[j][3] * v[j][3]; }
        ss = wave_sum(ss);
        const float rstd = rsqrtf(ss * (1.f / 1024.f) + EPS);
#pragma unroll
        for (int j = 0; j < 4; ++j) { const int c = j * 256 + lane * 4;
            const f32x4 g = *(const f32x4*)(gain + c), sh = *(const f32x4*)(mrow + c), sc = *(const f32x4*)(mrow + 1024 + c);
            const f32x4 y = (v[j] * rstd * g) * (sc + 1.f) + sh;
            u32x2 w; w.x = pk2(y[0], y[1]); w.y = pk2(y[2], y[3]);
            *(u32x2*)(out + (size_t)row * DM + c) = w; }
    }
}

__device__ __forceinline__ void final_norm_phase(float* __restrict__ x, const float* __restrict__ gain, int G, int bx) {
    const int wid = threadIdx.x >> 6, lane = threadIdx.x & 63;
    for (int row = bx * 8 + wid; row < ML; row += G * 8) {
        float* src = x + (size_t)row * DM;
        f32x4 v[4]; float ss = 0.f;
#pragma unroll
        for (int j = 0; j < 4; ++j) { v[j] = *(const f32x4*)(src + j * 256 + lane * 4); ss += v[j][0] * v[j][0] + v[j][1] * v[j][1] + v[j][2] * v[j][2] + v[j][3] * v[j][3]; }
        ss = wave_sum(ss);
        const float rstd = rsqrtf(ss * (1.f / 1024.f) + EPS);
#pragma unroll
        for (int j = 0; j < 4; ++j) { const int c = j * 256 + lane * 4; const f32x4 g = *(const f32x4*)(gain + c); *(f32x4*)(src + c) = v[j] * rstd * g; }
    }
}

__device__ __forceinline__ void qknorm_phase(bf16_t* __restrict__ QKV, const float* __restrict__ qg, const float* __restrict__ kg, const float2* __restrict__ rope, int G, int bx) {
    const int wid = threadIdx.x >> 6, lane = threadIdx.x & 63;
    const long total = (long)MQ * 6;
    for (long wi = (long)bx * 8 + wid; wi < total; wi += (long)G * 8) {
        const int row = (int)(wi / 6), slot = (int)(wi - (long)row * 6);
        const int b = row / LT, t = row - b * LT;
        const bool isctx = t >= LSEQ;
        if (isctx && slot < 4) continue;
        const int col0 = slot < 4 ? slot * 128 : 1024 + (slot - 4) * 128;
        const float* gw = slot < 4 ? qg : kg;
        unsigned* p = (unsigned*)(QKV + (size_t)row * NIN + col0) + lane;
        const unsigned raw = *p;
        float x0 = bf2f(raw & 0xffffu), x1 = bf2f(raw >> 16);
        const float ss = wave_sum(x0 * x0 + x1 * x1);
        const float rstd = rsqrtf(ss * (1.f / 128.f) + EPS);
        x0 = x0 * rstd * gw[2 * lane]; x1 = x1 * rstd * gw[2 * lane + 1];
        if (!isctx) {
            const int pos = lane < 32 ? (t >> 6) : (t & 63);
            const float2 cs = rope[pos * 32 + (lane & 31)];
            const float y0 = x0 * cs.x - x1 * cs.y, y1 = x0 * cs.y + x1 * cs.x; x0 = y0; x1 = y1;
        }
        *p = pk2(x0, x1);
    }
}

constexpr int NA_VPITCH = 144, NA_VBUF = 32 * NA_VPITCH;
constexpr int NA_MOFF = 8 * NA_VBUF;
__device__ __forceinline__ void na_item(const bf16_t* __restrict__ QKV, const float* __restrict__ rpb, bf16_t* __restrict__ MIX, int b, int hb, int r, LAS unsigned char* lds) {
    const int tid = threadIdx.x, wid = __builtin_amdgcn_readfirstlane(tid >> 6), lane = tid & 63, n = lane & 15, kq = lane >> 4;
    const int qg = wid & 3, kh = wid >> 2;
    const int c0 = qg * 16, kc0 = (qg == 0) ? 0 : (qg == 1) ? 8 : (qg == 2) ? 24 : 32;
    const int r0 = min(max(r - 4, 0), 56);
    const bf16_t* base = QKV + (size_t)b * LT * NIN;
    const bf16_t* qp = base + (size_t)(r * 64 + c0 + n) * NIN + 512 + hb * 64 + 8 * kq;
    const bf16x8 qf0 = *(const bf16x8*)qp, qf1 = *(const bf16x8*)(qp + 32);
    f32x4 s[16];
#pragma unroll
    for (int kb = 0; kb < 16; ++kb) {
        const int tok = kh == 0 ? ((r0 + (kb >> 1)) * 64 + kc0 + 16 * (kb & 1) + n) : (LSEQ + 16 * kb + n);
        const bf16_t* kp = base + (size_t)tok * NIN + 1536 + hb * 64 + 8 * kq;
        const bf16x8 a0 = *(const bf16x8*)kp, a1 = *(const bf16x8*)(kp + 32);
        f32x4 acc = {0.f, 0.f, 0.f, 0.f};
        acc = __builtin_amdgcn_mfma_f32_16x16x32_bf16(a0, qf0, acc, 0, 0, 0);
        acc = __builtin_amdgcn_mfma_f32_16x16x32_bf16(a1, qf1, acc, 0, 0, 0);
        s[kb] = acc;
    }
    float mx = -1e30f;
    if (kh == 0) {
        const int c = c0 + n, cs = min(max(c - 8, 0), 48);
        const float* rp = rpb + hb * 15 * 31;
#pragma unroll
        for (int kb = 0; kb < 16; ++kb) { const int i = kb >> 1, ro = r0 + i - r + 7;
#pragma unroll
            for (int j = 0; j < 4; ++j) { const int kc = kc0 + 16 * (kb & 1) + 4 * kq + j; const bool valid = (kc >= cs) && (kc < cs + 16);
                const int co = min(max(kc - c + 15, 0), 30);
                const float bias = rp[ro * 31 + co];
                const float v = valid ? s[kb][j] * 0.125f + bias : -1e30f; s[kb][j] = v; mx = fmaxf(mx, v); } }
    } else {
#pragma unroll
        for (int kb = 0; kb < 16; ++kb)
#pragma unroll
            for (int j = 0; j < 4; ++j) { const float v = s[kb][j] * 0.125f; s[kb][j] = v; mx = fmaxf(mx, v); }
    }
    mx = fmaxf(mx, __shfl_xor(mx, 16)); mx = fmaxf(mx, __shfl_xor(mx, 32));
    float lsum = 0.f;
#pragma unroll
    for (int kb = 0; kb < 16; ++kb)
#pragma unroll
        for (int j = 0; j < 4; ++j) { const float p = __builtin_amdgcn_exp2f((s[kb][j] - mx) * 1.4426950408889634f); s[kb][j] = p; lsum += p; }
    lsum += __shfl_xor(lsum, 16); lsum += __shfl_xor(lsum, 32);
    f32x4 o[4];
#pragma unroll
    for (int d = 0; d < 4; ++d) o[d] = (f32x4){0.f, 0.f, 0.f, 0.f};
    LAS unsigned char* vbuf = lds + wid * NA_VBUF;
    const int vrow = lane >> 1, vhalf = lane & 1;
    const LAS unsigned char* trp = vbuf + (4 * kq + (n >> 2)) * NA_VPITCH + (n & 3) * 8;
#pragma unroll
    for (int t = 0; t < 8; ++t) {
        const int tok0 = kh == 0 ? ((r0 + t) * 64 + kc0) : (LSEQ + 32 * t);
        const bf16_t* vp = base + (size_t)(tok0 + vrow) * NIN + 2048 + hb * 64 + vhalf * 32;
        const u32x4 v0 = *(const u32x4*)vp, v1 = *(const u32x4*)(vp + 8), v2 = *(const u32x4*)(vp + 16), v3 = *(const u32x4*)(vp + 24);
        LAS u32x4* wp = (LAS u32x4*)(vbuf + vrow * NA_VPITCH + vhalf * 64);
        wp[0] = v0; wp[1] = v1; wp[2] = v2; wp[3] = v3;
        u32x4 bw; bw.x = cvt_pk_bf16(s[2 * t][0], s[2 * t][1]); bw.y = cvt_pk_bf16(s[2 * t][2], s[2 * t][3]); bw.z = cvt_pk_bf16(s[2 * t + 1][0], s[2 * t + 1][1]); bw.w = cvt_pk_bf16(s[2 * t + 1][2], s[2 * t + 1][3]);
        const bf16x8 bfr = __builtin_bit_cast(bf16x8, bw);
#pragma unroll
        for (int d = 0; d < 4; ++d) {
            const s16x4 lo = vtr(trp + d * 32), hi = vtr(trp + 16 * NA_VPITCH + d * 32);
            const bf16x8 afr = (bf16x8){lo[0], lo[1], lo[2], lo[3], hi[0], hi[1], hi[2], hi[3]};
            o[d] = __builtin_amdgcn_mfma_f32_16x16x32_bf16(afr, bfr, o[d], 0, 0, 0);
        }
    }
    LAS float* mb = (LAS float*)(lds + NA_MOFF) + (qg * 64 + lane) * 18;
    if (kh == 1) { mb[0] = mx; mb[1] = lsum;
#pragma unroll
        for (int d = 0; d < 4; ++d)
#pragma unroll
            for (int j = 0; j < 4; ++j) mb[2 + d * 4 + j] = o[d][j]; }
    __syncthreads();
    if (kh == 0) {
        const float m1 = mb[0], l1 = mb[1];
        const float m = fmaxf(mx, m1), e0 = __builtin_amdgcn_exp2f((mx - m) * 1.4426950408889634f), e1 = __builtin_amdgcn_exp2f((m1 - m) * 1.4426950408889634f);
        const float inv = 1.f / (lsum * e0 + l1 * e1);
        bf16_t* op = MIX + (size_t)(b * LSEQ + r * 64 + c0 + n) * DM + 512 + hb * 64 + 4 * kq;
#pragma unroll
        for (int d = 0; d < 4; ++d) { float y[4];
#pragma unroll
            for (int j = 0; j < 4; ++j) y[j] = (o[d][j] * e0 + mb[2 + d * 4 + j] * e1) * inv;
            u32x2 w; w.x = pk2(y[0], y[1]); w.y = pk2(y[2], y[3]);
            *(u32x2*)(op + d * 16) = w; }
    }
    __syncthreads();
}

__device__ __forceinline__ void attention_phase(const bf16_t* __restrict__ QKV, const float* __restrict__ rpb, bf16_t* __restrict__ MIX, unsigned char* lds_g, LAS unsigned char* lds, int G, int vcu) {
    if (SEC(4)) for (int it = vcu; it < 256; it += G) {
        const int combo = it >> 5, w = it & 31, b = combo >> 1, kvh = combo & 1, g = w >> 4, qb = w & 15, h = kvh * 2 + g;
        const bf16_t* base = QKV + (size_t)b * LT * NIN;
        att::attn_dense_body(base + (size_t)(qb * 256) * NIN + h * 128, base + 1024 + kvh * 128, base + 1280 + kvh * 128,
                             MIX + (size_t)(b * LSEQ + qb * 256) * DM + h * 128, LT, (char*)lds_g);
    }
    const int per = (2048 + G - 1) / G;
    if (SEC(5)) for (int it = vcu * per; it < min(2048, (vcu + 1) * per); ++it) {
        const int combo = it >> 6, r = it & 63, b = combo >> 3, hb = combo & 7;
        na_item(QKV, rpb, MIX, b, hb, r, lds);
    }
}

__device__ __forceinline__ void convgate_phase(const bf16_t* __restrict__ U, bf16_t* __restrict__ ACT, const float* __restrict__ cw, const float* __restrict__ cb, int chunk, int G, int bx) {
    constexpr int RCH = 8, NCV = FF / 8;
    const long total = (long)(CHROWS / RCH) * NCV;
    for (long idx = (long)bx * 512 + threadIdx.x; idx < total; idx += (long)G * 512) {
        const int cv = (int)(idx % NCV), rc = (int)(idx / NCV);
        const int c = cv * 8, np = (c >> 7) * 256 + (c & 127);
        const int t0 = rc * RCH;
        float wg[3][8], wv[3][8], bg[8], bv[8];
#pragma unroll
        for (int j = 0; j < 3; ++j)
#pragma unroll
            for (int e = 0; e < 8; ++e) { wg[j][e] = cw[j * NUP + c + e]; wv[j][e] = cw[j * NUP + FF + c + e]; }
#pragma unroll
        for (int e = 0; e < 8; ++e) { bg[e] = cb[c + e]; bv[e] = cb[FF + c + e]; }
        float pg[8], pv[8], cg_[8], cv_[8], ng[8], nv[8];
        auto ld = [&](int t, float* g8, float* v8) {
            if (t < 0 || t >= CHROWS || ((t >> 12) != (t0 >> 12))) {
#pragma unroll
                for (int e = 0; e < 8; ++e) { g8[e] = 0.f; v8[e] = 0.f; }
            } else {
                const u32x4 a = *(const u32x4*)(U + (size_t)t * NUP + np), bq = *(const u32x4*)(U + (size_t)t * NUP + np + 128);
#pragma unroll
                for (int e = 0; e < 4; ++e) { g8[2 * e] = bf2f(a[e] & 0xffffu); g8[2 * e + 1] = bf2f(a[e] >> 16); v8[2 * e] = bf2f(bq[e] & 0xffffu); v8[2 * e + 1] = bf2f(bq[e] >> 16); }
            }
        };
        ld(t0 - 1, pg, pv); ld(t0, cg_, cv_);
#pragma unroll
        for (int i = 0; i < RCH; ++i) {
            ld(t0 + i + 1, ng, nv);
            float y[8];
#pragma unroll
            for (int e = 0; e < 8; ++e) {
                const float gg = pg[e] * wg[0][e] + cg_[e] * wg[1][e] + ng[e] * wg[2][e] + bg[e];
                const float vv = pv[e] * wv[0][e] + cv_[e] * wv[1][e] + nv[e] * wv[2][e] + bv[e];
                y[e] = gg / (1.f + __expf(-gg)) * vv;
            }
            u32x4 w; w.x = pk2(y[0], y[1]); w.y = pk2(y[2], y[3]); w.z = pk2(y[4], y[5]); w.w = pk2(y[6], y[7]);
            *(u32x4*)(ACT + ((size_t)chunk * CHROWS + t0 + i) * FF + c) = w;
#pragma unroll
            for (int e = 0; e < 8; ++e) { pg[e] = cg_[e]; pv[e] = cv_[e]; cg_[e] = ng[e]; cv_[e] = nv[e]; }
        }
    }
}

template <int STAGE>
__device__ __forceinline__ void fft_phase(const bf16_t* __restrict__ IN, bf16_t* __restrict__ OUT, const bf16_t* __restrict__ F, const float2* __restrict__ TW, LAS unsigned char* lds, int G, int bx) {
    constexpr int MB = STAGE == 1 ? 8 : 4, PITCH = 528;
    const int tid = threadIdx.x, wid = __builtin_amdgcn_readfirstlane(tid >> 6), lane = tid & 63, n = lane & 15, kq = lane >> 4;
    for (int it = bx; it < 1024; it += G) {
        const int g = it & 3, t = (it >> 2) & 63, b = it >> 8;
#pragma unroll
        for (int i = 0; i < 8; ++i) { const int cid = tid + 512 * i, row = cid >> 5, cc = cid & 31, ri = row >> 6, tt = row & 63;
            const size_t srow = STAGE == 1 ? ((size_t)b * 4096 + tt * 64 + t) : (((size_t)b * 64 + t) * 64 + tt);
            const u32x4 v = *(const u32x4*)(IN + srow * 2048 + g * 512 + ri * 256 + cc * 8);
            *(LAS u32x4*)(lds + row * PITCH + cc * 16) = v; }
        __syncthreads();
        f32x4 acc[MB][2];
#pragma unroll
        for (int mb = 0; mb < MB; ++mb) { acc[mb][0] = (f32x4){0.f, 0.f, 0.f, 0.f}; acc[mb][1] = (f32x4){0.f, 0.f, 0.f, 0.f}; }
#pragma unroll 1
        for (int ks = 0; ks < 4; ++ks) {
            bf16x8 bfr[2];
#pragma unroll
            for (int j = 0; j < 2; ++j) { const int nb = 2 * wid + j;
                const LAS unsigned char* p = lds + (ks * 32 + 8 * kq + (n >> 2)) * PITCH + (nb * 16 + 4 * (n & 3)) * 2;
                const s16x4 lo = vtr(p), hi = vtr(p + 4 * PITCH);
                bfr[j] = (bf16x8){lo[0], lo[1], lo[2], lo[3], hi[0], hi[1], hi[2], hi[3]}; }
#pragma unroll
            for (int mb = 0; mb < MB; ++mb) { const bf16x8 afr = *(const bf16x8*)(F + (mb * 16 + n) * 128 + ks * 32 + 8 * kq);
                acc[mb][0] = __builtin_amdgcn_mfma_f32_16x16x32_bf16(afr, bfr[0], acc[mb][0], 0, 0, 0);
                acc[mb][1] = __builtin_amdgcn_mfma_f32_16x16x32_bf16(afr, bfr[1], acc[mb][1], 0, 0, 0); }
        }
        if constexpr (STAGE == 1) {
#pragma unroll
            for (int mb = 0; mb < 4; ++mb)
#pragma unroll
                for (int jj = 0; jj < 4; ++jj) { const int k1 = mb * 16 + 4 * kq + jj; const float2 cs = TW[k1 * t];
                    bf16_t* orow = OUT + (((size_t)b * 64 + k1) * 64 + t) * 2048 + g * 512;
#pragma unroll
                    for (int j = 0; j < 2; ++j) { const float re = acc[mb][j][jj], im = acc[mb + 4][j][jj]; const int col = (2 * wid + j) * 16 + n;
                        orow[col] = (bf16_t)f2bf(re * cs.x + im * cs.y); orow[256 + col] = (bf16_t)f2bf(im * cs.x - re * cs.y); } }
        } else {
#pragma unroll
            for (int mb = 0; mb < 4; ++mb)
#pragma unroll
                for (int jj = 0; jj < 4; ++jj) { const int k2 = mb * 16 + 4 * kq + jj;
                    bf16_t* orow = OUT + ((size_t)b * 4096 + t + 64 * k2) * 1024 + g * 256;
#pragma unroll
                    for (int j = 0; j < 2; ++j) orow[(2 * wid + j) * 16 + n] = (bf16_t)f2bf(acc[mb][j][jj] * (1.f / 1024.f)); }
        }
        __syncthreads();
    }
}

#define FFN_LAYER(l) \
    if (SEC(1) && RUN) norm_mod_phase(a.out, nullptr, false, a.in[I_N2G] + (l) * DM, MOD + (size_t)(l) * 5 * 6144, 3, H, G, bx); \
    SEAM(); \
    if (RUN) { pg8::Gemm g{H, (const bf16_t*)(ws + WS_WUP) + (size_t)(l) * NUP * DM, DM, DM, DM, 30, 254, -1}; pg8::StaticOrder S; S.init_tiles(65, NUP / 256, G, bx); \
        pg8::EpiConvGate E{ACT, a.in[I_CW] + (size_t)(l) * 3 * NUP, a.in[I_CB] + (size_t)(l) * NUP}; if (SEC(2)) pg8::gemm_phase(lds, g, S, E); } \
    SEAM(); \
    if (RUN) { pg8::Gemm g{ACT, (const bf16_t*)(ws + WS_WDN) + (size_t)(l) * DM * FF, FF, FF, FF, 30, 256, 0}; pg8::StaticOrder S; S.init(ML, DM, G, bx); pg8::EpiResid E{a.out, a.out, MOD + (size_t)(l) * 5 * 6144 + 5 * 1024}; if (SEC(6)) pg8::gemm_phase(lds, g, S, E); } \
    SEAM();
constexpr int NPH = 10 + 4 * NCH + 10;
__global__ void __launch_bounds__(512, 2) fwd_kernel(Args a) {
    extern __shared__ __attribute__((aligned(16))) unsigned char lds_g[];
    LAS unsigned char* lds = (LAS unsigned char*)lds_g;
    const int G = gridDim.x, bx = blockIdx.x;
    const int vcu = (G % 8 == 0) ? (bx % 8) * (G / 8) + bx / 8 : bx;
    unsigned char* ws = a.ws;
    bf16_t* H = (bf16_t*)(ws + WS_H); bf16_t* QKV = (bf16_t*)(ws + WS_QKV); bf16_t* MIX = (bf16_t*)(ws + WS_MIX);
    bf16_t* ACT = (bf16_t*)(ws + WS_ACT);
    bf16_t* Z = (bf16_t*)(ws + WS_Z); bf16_t* A1 = (bf16_t*)(ws + WS_A1); bf16_t* Y = (bf16_t*)(ws + WS_Y);
    float* MOD = (float*)(ws + WS_MOD);
    const int lo = a.ph_lo, hi = a.ph_hi;
    int ph = 0;
    volatile LAS unsigned* xst = (volatile LAS unsigned*)(lds + LDS_BYTES - 16);
    if (threadIdx.x == 0) { xst[0] = 0u; xst[1] = 0u; }
    __syncthreads();
    const XcdBarrier xbar = xcd_barrier_post((unsigned*)(ws + WS_BAR), xst);
    if (hi < 0) cg::this_grid().sync();
#if MK_SPLIT
#define SEAM() do { ++ph; } while (0)
#else
#define SEAM() do { if (lo <= ph && ph + 1 < hi) xcd_barrier(xbar); ++ph; } while (0)
#endif
#define RUN (lo <= ph && ph < hi)


    if (SEC(0) && RUN) p0_prologue(a, lds, G, bx);
    SEAM();
    if (SEC(1) && RUN) norm_mod_phase(a.in[I_X], a.in[I_CTX], true, a.in[I_N1G], MOD, 0, H, G, bx);
    SEAM();
    if (RUN) { pg8::Gemm g{H, (const bf16_t*)(ws + WS_WIN), DM, DM, DM, 30, 256, 0}; pg8::StaticOrder S; S.init(MQ, NIN, G, bx); pg8::EpiStore E{QKV, NIN}; if (SEC(2)) pg8::gemm_phase(lds, g, S, E); }
    SEAM();
    if (SEC(3) && RUN) qknorm_phase(QKV, a.in[I_QG], a.in[I_KG], (const float2*)(ws + WS_ROPE), G, bx);
    SEAM();
    if ((SEC(4) || SEC(5)) && RUN) attention_phase(QKV, a.in[I_RPB], MIX, lds_g, lds, G, vcu);
    SEAM();
    if (RUN) { pg8::Gemm g{MIX, (const bf16_t*)(ws + WS_WO), DM, DM, DM, 30, 256, 0}; pg8::StaticOrder S; S.init(ML, DM, G, bx); pg8::EpiResid E{a.in[I_X], a.out, MOD + 2048}; if (SEC(6)) pg8::gemm_phase(lds, g, S, E); }
    SEAM();
    FFN_LAYER(0);
    if (SEC(1) && RUN) norm_mod_phase(a.out, nullptr, false, a.in[I_N1G] + DM, MOD + 5 * 6144, 0, H, G, bx);
    SEAM();
    if (RUN) { pg8::Gemm g{H, (const bf16_t*)(ws + WS_DFTC), DM, 256, 256, 1, 256, 0}; pg8::StaticOrder S; S.init(ML, 2048, G, bx); pg8::EpiStore E{Z, 2048}; if (SEC(2)) pg8::gemm_phase(lds, g, S, E); }
    SEAM();
    if (SEC(7) && RUN) fft_phase<1>(Z, A1, (const bf16_t*)(ws + WS_F1), (const float2*)(ws + WS_TW), lds, G, bx);
    SEAM();
    if (SEC(7) && RUN) fft_phase<2>(A1, Y, (const bf16_t*)(ws + WS_F2), (const float2*)(ws + WS_TW), lds, G, bx);
    SEAM();
    if (RUN) { pg8::Gemm g{Y, (const bf16_t*)(ws + WS_WF), DM, DM, DM, 30, 256, 0}; pg8::StaticOrder S; S.init(ML, DM, G, bx); pg8::EpiResid E{a.out, a.out, MOD + 5 * 6144 + 2048}; if (SEC(6)) pg8::gemm_phase(lds, g, S, E); }
    SEAM();
    FFN_LAYER(1);
    if (SEC(9) && RUN) final_norm_phase(a.out, a.in[I_FG], G, bx);
#undef SEAM
#undef RUN
}

extern "C" void kernel_launch(void* const* d_in, const int* in_sizes, int n_in, void* d_out, int out_size, void* d_ws, size_t ws_size, hipStream_t stream) {
    static int grid = 0;
    if (grid == 0) {
        if (n_in != 19 || in_sizes[0] != ML * DM || out_size != ML * DM || ws_size < WS_END) { fprintf(stderr, "kernel_launch: unexpected shapes (n_in %d, in0 %d, out %d, ws %zu < %zu)\n", n_in, n_in > 0 ? in_sizes[0] : -1, out_size, ws_size, (size_t)WS_END); grid = -1; return; }
        int dev = 0, cus = 0, per_cu = 0;
        hipGetDevice(&dev);
        hipDeviceGetAttribute(&cus, hipDeviceAttributeMultiprocessorCount, dev);
        if (hipFuncSetAttribute((const void*)fwd_kernel, hipFuncAttributeMaxDynamicSharedMemorySize, LDS_BYTES) != hipSuccess) { fprintf(stderr, "kernel_launch: hipFuncSetAttribute failed\n"); grid = -1; return; }
        if (hipOccupancyMaxActiveBlocksPerMultiprocessor(&per_cu, (const void*)fwd_kernel, 512, LDS_BYTES) != hipSuccess || per_cu < 1) { fprintf(stderr, "kernel_launch: occupancy query says %d\n", per_cu); per_cu = 1; }
        (void)hipGetLastError();
        grid = cus * (per_cu > 1 ? 1 : per_cu);
        if (grid <= 0) grid = 256;
    }
    if (grid < 0) return;
    Args a{};
    for (int i = 0; i < 19; ++i) a.in[i] = (const float*)d_in[i];
    a.out = (float*)d_out; a.ws = (unsigned char*)d_ws;
#if MK_SPLIT
    for (int p = 0; p < NPH + 2; ++p) { a.ph_lo = p; a.ph_hi = p + 1; hipLaunchKernelGGL(fwd_kernel, dim3(grid), dim3(512), LDS_BYTES, stream, a); }
#else
    a.ph_lo = 0; a.ph_hi = 1000;
    if (hipMemsetAsync((char*)d_ws + WS_BAR, 0, 16384, stream) != hipSuccess) { fprintf(stderr, "kernel_launch: memset failed\n"); return; }
    void* args[] = {&a};
    hipError_t e = hipLaunchCooperativeKernel((const void*)fwd_kernel, dim3(grid), dim3(512), args, LDS_BYTES, stream);
    if (e != hipSuccess) fprintf(stderr, "kernel_launch: cooperative launch failed: %s (grid %d)\n", hipGetErrorString(e), grid);
#endif
}
```

```cpp
#include <hip/hip_runtime.h>
#include <hip/hip_cooperative_groups.h>
#include <cstdio>
#include <cstdint>
namespace cg = cooperative_groups;

#define LAS __attribute__((address_space(3)))
typedef unsigned short bf16_t;
typedef short bf16x8 __attribute__((ext_vector_type(8)));
typedef short s16x4 __attribute__((ext_vector_type(4)));
typedef short v4i16_t __attribute__((ext_vector_type(4)));
typedef float f32x4 __attribute__((ext_vector_type(4)));
typedef float f32x8 __attribute__((ext_vector_type(8)));
typedef float f32x16 __attribute__((ext_vector_type(16)));
typedef unsigned u32x4 __attribute__((ext_vector_type(4)));
typedef unsigned u32x2 __attribute__((ext_vector_type(2)));

#ifndef SECMASK
#define SECMASK 0xFFFF
#endif
#define SEC(k) ((SECMASK >> (k)) & 1)
#ifndef MK_SPLIT
#define MK_SPLIT 0
#endif

constexpr int NB = 4, LSEQ = 4096, CTXL = 256, LT = LSEQ + CTXL, MQ = NB * LT, ML = NB * LSEQ, DM = 1024, NIN = 2560, FF = 2816, NUP = 5632;
constexpr int NCH = 2, CHROWS = ML / NCH;
constexpr float EPS = 1e-6f;

constexpr size_t WS_WIN = 0;
constexpr size_t WS_WO = WS_WIN + (size_t)NIN * DM * 2;
constexpr size_t WS_WF = WS_WO + (size_t)DM * DM * 2;
constexpr size_t WS_WUP = WS_WF + (size_t)DM * DM * 2;
constexpr size_t WS_WDN = WS_WUP + 2 * (size_t)NUP * DM * 2;
constexpr size_t WS_DFTC = WS_WDN + 2 * (size_t)DM * FF * 2;
constexpr size_t WS_F1 = WS_DFTC + 512 * 256 * 2;
constexpr size_t WS_F2 = WS_F1 + 128 * 128 * 2;
constexpr size_t WS_TW = WS_F2 + 64 * 128 * 2;
constexpr size_t WS_ROPE = WS_TW + 4096 * 8;
constexpr size_t WS_BAR = WS_ROPE + 64 * 32 * 8;
constexpr size_t WS_MOD = WS_BAR + 16384;
constexpr size_t WS_H = WS_MOD + 2 * 5 * 6144 * 4 + (512 << 10);
constexpr size_t WS_R0 = WS_H + (size_t)MQ * DM * 2 + (512 << 10);
constexpr size_t WS_QKV = WS_R0, WS_MIX = WS_QKV + (size_t)MQ * NIN * 2;
constexpr size_t WS_ACT = WS_R0;
constexpr size_t WS_Z = WS_R0, WS_A1 = WS_Z + (size_t)ML * 2048 * 2, WS_Y = WS_A1 + (size_t)ML * 2048 * 2;
constexpr size_t WS_END0 = WS_ACT + (size_t)ML * FF * 2, WS_END1 = WS_Y + (size_t)ML * DM * 2, WS_END2 = WS_MIX + (size_t)ML * DM * 2;
constexpr size_t WS_END = WS_END0 > WS_END1 ? (WS_END0 > WS_END2 ? WS_END0 : WS_END2) : (WS_END1 > WS_END2 ? WS_END1 : WS_END2);
static_assert(WS_END <= 268435456ull, "workspace map exceeds 256 MiB");
static_assert(WS_H % 256 == 0 && WS_R0 % 256 == 0 && WS_MOD % 256 == 0, "alignment");

constexpr int LDS_BYTES = 147456;

__device__ __forceinline__ unsigned f2bf(float f) { unsigned u = __float_as_uint(f); return (u + 0x7fffu + ((u >> 16) & 1u)) >> 16; }
__device__ __forceinline__ unsigned pk2(float lo, float hi) { return f2bf(lo) | (f2bf(hi) << 16); }
__device__ __forceinline__ float bf2f(unsigned v) { return __uint_as_float(v << 16); }
__device__ __forceinline__ unsigned cvt_pk_bf16(float lo, float hi) { unsigned r; asm volatile("v_cvt_pk_bf16_f32 %0, %1, %2" : "=v"(r) : "v"(lo), "v"(hi)); return r; }
__device__ __forceinline__ float wave_sum(float v) {
#pragma unroll
    for (int o = 1; o < 64; o <<= 1) v += __shfl_xor(v, o);
    return v;
}

namespace pg8 {
constexpr int BM = 256, BK = 64, HALF = 128, HTB = HALF * BK * 2, STAGE_BYTES = 8 * HTB, NXCD = 8, WGM = 8;
__host__ __device__ __forceinline__ int lds_byte(int r, int c) { const int st = (r >> 4) * 2 + (c >> 5), rr = r & 15, cc = c & 31, ob = rr * 64 + cc * 2; return st * 1024 + (ob ^ (((ob >> 9) & 1) << 5)); }
__host__ __device__ __forceinline__ void stage_rc(int b, int& R, int& C) { const int st = b / 1024, sb = b % 1024, swz = sb ^ (((sb >> 9) & 1) << 5); R = (st >> 1) * 16 + swz / 64; C = (st & 1) * 32 + (swz % 64) / 2; }
__host__ __device__ __forceinline__ int perm32(int rho) { const int n = rho >> 4, i = rho & 15; return 8 * (i >> 2) + 4 * n + (i & 3); }

struct Unit { int pm, pn; };
struct Gemm { const bf16_t* A; const bf16_t* Bt; int lda, ldb, K, gs, mstep, moff; };

struct StaticOrder {
    int nM, nN, nwg, G, c;
    __host__ __device__ void init(int M, int N, int G_, int c_) { nM = M / BM; nN = N / BM; nwg = nM * nN; G = G_; c = c_; }
    __host__ __device__ void init_tiles(int nM_, int nN_, int G_, int c_) { nM = nM_; nN = nN_; nwg = nM * nN; G = G_; c = c_; }
    __host__ __device__ bool next(int i, Unit& u) const {
        const long L = (long)i * G + c; if (L >= nwg) return false;
        int wgid = (int)L; { const int q = nwg / NXCD, r = nwg % NXCD, xcd = wgid % NXCD, off = wgid / NXCD; wgid = (xcd < r ? xcd * (q + 1) : r * (q + 1) + (xcd - r) * q) + off; }
        const int nig = WGM * nN, gid = wgid / nig, fm = gid * WGM, gsz = (nM - fm) < WGM ? (nM - fm) : WGM;
        u.pm = fm + ((wgid % nig) % gsz); u.pn = (wgid % nig) / gsz; return true;
    }
};

struct EpiStore {
    static constexpr bool PERM = true;
    bf16_t* O; int ldc;
    __device__ __forceinline__ void operator()(const f32x4 (&acc)[2][2][4][2], const Unit& u, int wr, int wc, int fr, int fq, LAS unsigned char*) const {
        const int row0 = u.pm * BM + wr * 64 + fr, col0 = u.pn * BM + wc * 32 + 8 * fq;
#pragma unroll
        for (int ai = 0; ai < 2; ++ai)
#pragma unroll
            for (int m = 0; m < 4; ++m) { bf16_t* rowp = O + (size_t)(row0 + ai * HALF + m * 16) * ldc + col0;
#pragma unroll
                for (int bj = 0; bj < 2; ++bj) { const f32x4 v0 = acc[ai][bj][m][0], v1 = acc[ai][bj][m][1];
                    u32x4 w; w.x = cvt_pk_bf16(v0[0], v0[1]); w.y = cvt_pk_bf16(v0[2], v0[3]); w.z = cvt_pk_bf16(v1[0], v1[1]); w.w = cvt_pk_bf16(v1[2], v1[3]);
                    *(u32x4*)(rowp + bj * HALF) = w; } }
    }
};
struct EpiResid {
    static constexpr bool PERM = true;
    const float* R; float* O; const float* gate;
    __device__ __forceinline__ void operator()(const f32x4 (&acc)[2][2][4][2], const Unit& u, int wr, int wc, int fr, int fq, LAS unsigned char*) const {
        const int row0 = u.pm * BM + wr * 64 + fr, col0 = u.pn * BM + wc * 32 + 8 * fq;
        const float* gp = gate + (size_t)((u.pm * BM) >> 12) * 6144 + col0;
        f32x4 gv[2][2];
#pragma unroll
        for (int bj = 0; bj < 2; ++bj)
#pragma unroll
            for (int n = 0; n < 2; ++n) gv[bj][n] = *(const f32x4*)(gp + bj * HALF + 4 * n);
#pragma unroll
        for (int ai = 0; ai < 2; ++ai)
#pragma unroll
            for (int m = 0; m < 4; ++m) { const size_t ro = (size_t)(row0 + ai * HALF + m * 16) * DM + col0;
#pragma unroll
                for (int bj = 0; bj < 2; ++bj)
#pragma unroll
                    for (int n = 0; n < 2; ++n) { const size_t idx = ro + bj * HALF + 4 * n;
                        const f32x4 r = *(const f32x4*)(R + idx);
                        *(f32x4*)(O + idx) = r + gv[bj][n] * acc[ai][bj][m][n]; } }
    }
};

__device__ __forceinline__ float dppf(float old, float src, const int ctrl_sel) {
    const int o = __float_as_int(old), v = __float_as_int(src); int r;
    if (ctrl_sel == 0) r = __builtin_amdgcn_update_dpp(o, v, 0x111, 0xf, 0xf, false);
    else if (ctrl_sel == 1) r = __builtin_amdgcn_update_dpp(o, v, 0x101, 0xf, 0xf, false);
    else if (ctrl_sel == 2) r = __builtin_amdgcn_update_dpp(o, v, 0x121, 0xf, 0xf, false);
    else r = __builtin_amdgcn_update_dpp(o, v, 0x12F, 0xf, 0xf, false);
    return __int_as_float(r);
}
struct EpiConvGate {
    static constexpr bool PERM = true;
    bf16_t* ACT; const float* cw; const float* cb;
    __device__ __forceinline__ void operator()(const f32x4 (&acc)[2][2][4][2], const Unit& u, int wr, int wc, int fr, int fq, LAS unsigned char* xl) const {
        LAS float* X = (LAS float*)xl;
#define XIDX(w_r, a_i, e_d, b_j) ((((((w_r) * 4 + wc) * 2 + (a_i)) * 2 + (e_d)) * 2 + (b_j)) * 32 + 8 * fq)
        if (fr == 0) {
#pragma unroll
            for (int ai = 0; ai < 2; ++ai)
#pragma unroll
                for (int bj = 0; bj < 2; ++bj)
#pragma unroll
                    for (int n = 0; n < 2; ++n) *(LAS f32x4*)&X[XIDX(wr, ai, 0, bj) + 4 * n] = acc[ai][bj][0][n];
        }
        if (fr == 15) {
#pragma unroll
            for (int ai = 0; ai < 2; ++ai)
#pragma unroll
                for (int bj = 0; bj < 2; ++bj)
#pragma unroll
                    for (int n = 0; n < 2; ++n) *(LAS f32x4*)&X[XIDX(wr, ai, 1, bj) + 4 * n] = acc[ai][bj][3][n];
        }
        asm volatile("s_waitcnt lgkmcnt(0)" ::: "memory");
        __builtin_amdgcn_s_barrier();
        const int grow0 = u.pm * 254 - 1;
#pragma unroll
        for (int n = 0; n < 2; ++n) {
            const int col = u.pn * 128 + wc * 32 + 8 * fq + 4 * n;
            const f32x4 wg0 = *(const f32x4*)(cw + col), wg1 = *(const f32x4*)(cw + NUP + col), wg2 = *(const f32x4*)(cw + 2 * NUP + col), bg = *(const f32x4*)(cb + col);
            const f32x4 wv0 = *(const f32x4*)(cw + FF + col), wv1 = *(const f32x4*)(cw + NUP + FF + col), wv2 = *(const f32x4*)(cw + 2 * NUP + FF + col), bv = *(const f32x4*)(cb + FF + col);
#pragma unroll
            for (int ai = 0; ai < 2; ++ai) {
                f32x4 ep[2], en[2];
#pragma unroll
                for (int bj = 0; bj < 2; ++bj) {
                    if (wr == 1) ep[bj] = *(LAS f32x4*)&X[XIDX(0, ai, 1, bj) + 4 * n];
                    else if (ai == 1) ep[bj] = *(LAS f32x4*)&X[XIDX(1, 0, 1, bj) + 4 * n];
                    else ep[bj] = (f32x4){0.f, 0.f, 0.f, 0.f};
                    if (wr == 0) en[bj] = *(LAS f32x4*)&X[XIDX(1, ai, 0, bj) + 4 * n];
                    else if (ai == 0) en[bj] = *(LAS f32x4*)&X[XIDX(0, 1, 0, bj) + 4 * n];
                    else en[bj] = (f32x4){0.f, 0.f, 0.f, 0.f};
                }
#pragma unroll
                for (int m = 0; m < 4; ++m) {
                    const int r = ai * 128 + wr * 64 + m * 16 + fr, gr = grow0 + r;
                    const bool pz = (gr & 4095) == 0, nz = (gr & 4095) == 4095;
                    f32x4 pv[2], nv[2];
#pragma unroll
                    for (int bj = 0; bj < 2; ++bj)
#pragma unroll
                        for (int j = 0; j < 4; ++j) {
                            const float cur = acc[ai][bj][m][n][j];
                            const float pe = (m > 0) ? dppf(0.f, acc[ai][bj][m > 0 ? m - 1 : 0][n][j], 2) : ep[bj][j];
                            const float ne = (m < 3) ? dppf(0.f, acc[ai][bj][m < 3 ? m + 1 : 3][n][j], 3) : en[bj][j];
                            const float p = dppf(pe, cur, 0), q = dppf(ne, cur, 1);
                            pv[bj][j] = pz ? 0.f : p; nv[bj][j] = nz ? 0.f : q;
                        }
                    const f32x4 gg = pv[0] * wg0 + acc[ai][0][m][n] * wg1 + nv[0] * wg2 + bg;
                    const f32x4 vv = pv[1] * wv0 + acc[ai][1][m][n] * wv1 + nv[1] * wv2 + bv;
                    float y[4];
#pragma unroll
                    for (int j = 0; j < 4; ++j) y[j] = gg[j] * __builtin_amdgcn_rcpf(1.f + __expf(-gg[j])) * vv[j];
                    if (r >= 1 && r <= 254 && gr < ML) {
                        u32x2 w; w.x = cvt_pk_bf16(y[0], y[1]); w.y = cvt_pk_bf16(y[2], y[3]);
                        *(u32x2*)(ACT + (size_t)gr * FF + col) = w;
                    }
                }
            }
        }
#undef XIDX
    }
};

template <class Epi>
__device__ __forceinline__ void gemm_phase(LAS unsigned char* lds, const Gemm g, const StaticOrder& S, const Epi& E) {
    const int tid = threadIdx.x, wid = __builtin_amdgcn_readfirstlane(tid >> 6), lane = tid & 63, wr = wid >> 2, wc = wid & 3, fr = lane & 15, fq = lane >> 4;
    const int K = g.K, nt = K / BK;
    unsigned voffA[2], voffB[2];
#pragma unroll
    for (int i = 0; i < 2; ++i) { int R, C; stage_rc(tid * 16 + i * 8192, R, C); const int Rb = Epi::PERM ? ((R & ~31) + perm32(R & 31)) : R;
        voffA[i] = (unsigned)(R * g.lda + C) * 2u; voffB[i] = (unsigned)(Rb * g.ldb + C) * 2u; }
    const size_t kstep = (size_t)(BK * 2);
    const size_t hstepA = (size_t)HALF * g.lda * 2, hstepB = (size_t)HALF * g.ldb * 2;
    const unsigned ldsw = (unsigned)wid * 1024u;
    const int aoff = lds_byte(wr * 64 + fr, fq * 8), boff = lds_byte(wc * 32 + fr, fq * 8);
    const int gmask = (1 << g.gs) - 1;
#define PG8_APTR(u) ((const char*)g.A + ((long)(u).pm * g.mstep + g.moff) * (long)g.lda * 2 + (size_t)((u).pn >> g.gs) * (size_t)K * 2)
#define PG8_BPTR(u) ((const char*)g.Bt + (size_t)((u).pn & gmask) * 2 * hstepB)
#define PG8_SA(b, h) (((b) * 2 + (h)) * HTB)
#define PG8_SB(b, h) ((4 + (b) * 2 + (h)) * HTB)
#define PG8_STAGE(bufoff, gbase, voff) do { _Pragma("unroll") for (int _i = 0; _i < 2; ++_i) \
        __builtin_amdgcn_global_load_lds((const unsigned*)((const char*)(gbase) + (voff)[_i]), (LAS unsigned*)(lds + (bufoff) + ldsw + _i * 8192), 16, 0, 0); } while (0)
#define PG8_LDA(dst, b, h) do { _Pragma("unroll") for (int m = 0; m < 4; ++m) _Pragma("unroll") for (int k = 0; k < 2; ++k) dst[m][k] = *(const LAS bf16x8*)(lds + PG8_SA(b, h) + aoff + m * 2048 + k * 1024); } while (0)
#define PG8_LDB(dst, b, h) do { _Pragma("unroll") for (int n = 0; n < 2; ++n) _Pragma("unroll") for (int k = 0; k < 2; ++k) dst[n][k] = *(const LAS bf16x8*)(lds + PG8_SB(b, h) + boff + n * 2048 + k * 1024); } while (0)
#define PG8_MMA(ai, bj, At, Bt) do { __builtin_amdgcn_s_setprio(1); _Pragma("unroll") for (int m = 0; m < 4; ++m) _Pragma("unroll") for (int n = 0; n < 2; ++n) _Pragma("unroll") for (int k = 0; k < 2; ++k) \
        acc[ai][bj][m][n] = __builtin_amdgcn_mfma_f32_16x16x32_bf16(Bt[n][k], At[m][k], acc[ai][bj][m][n], 0, 0, 0); __builtin_amdgcn_s_setprio(0); } while (0)
#define PG8_WAIT_V(n) asm volatile("s_waitcnt vmcnt(" #n ")" ::: "memory")
#define PG8_WAIT_L(n) asm volatile("s_waitcnt lgkmcnt(" #n ")" ::: "memory")
#define PG8_BAR __builtin_amdgcn_s_barrier()
#define PG8_SCHED __builtin_amdgcn_sched_barrier(0)
    Unit cur, nxt; int ui = 0;
    if (!S.next(0, cur)) return;
    f32x4 acc[2][2][4][2];
#pragma unroll
    for (int a = 0; a < 2; ++a)
#pragma unroll
        for (int b = 0; b < 2; ++b)
#pragma unroll
            for (int m = 0; m < 4; ++m)
#pragma unroll
                for (int n = 0; n < 2; ++n) acc[a][b][m][n] = (f32x4){0.f, 0.f, 0.f, 0.f};
    bf16x8 At[4][2], B0[2][2], B1[2][2];
    const char* cA = PG8_APTR(cur); const char* cB = PG8_BPTR(cur);
    PG8_STAGE(PG8_SB(0, 0), cB, voffB); PG8_STAGE(PG8_SB(0, 1), cB + hstepB, voffB); PG8_STAGE(PG8_SA(0, 0), cA, voffA); PG8_STAGE(PG8_SA(0, 1), cA + hstepA, voffA);
    if (wr == 1) PG8_BAR;
    PG8_WAIT_V(2); PG8_BAR;
    PG8_STAGE(PG8_SB(1, 0), cB + kstep, voffB); PG8_STAGE(PG8_SA(1, 0), cA + kstep, voffA); PG8_STAGE(PG8_SB(1, 1), cB + hstepB + kstep, voffB);
    PG8_WAIT_V(6); PG8_BAR;
    for (;;) {
        const bool has_next = S.next(ui + 1, nxt);
        const char* nA = has_next ? PG8_APTR(nxt) : cA; const char* nB = has_next ? PG8_BPTR(nxt) : cB;
        for (int t = 0; t < nt; t += 2) {
            const bool last = (t == nt - 2);
            const char* a1 = cA + (size_t)(t + 1) * kstep;
            const char* a2 = last ? nA : cA + (size_t)(t + 2) * kstep; const char* b2 = last ? nB : cB + (size_t)(t + 2) * kstep;
            const char* a3 = a2 + kstep; const char* b3 = b2 + kstep;
            PG8_LDB(B0, 0, 0); PG8_LDB(B1, 0, 1); PG8_SCHED; PG8_LDA(At, 0, 0); PG8_STAGE(PG8_SA(1, 1), a1 + hstepA, voffA);
            PG8_WAIT_V(8); PG8_WAIT_L(0); PG8_BAR; PG8_MMA(0, 0, At, B0); PG8_MMA(0, 1, At, B1); PG8_BAR; PG8_SCHED;
            PG8_LDA(At, 0, 1); PG8_STAGE(PG8_SB(0, 0), b2, voffB); PG8_STAGE(PG8_SB(0, 1), b2 + hstepB, voffB); PG8_STAGE(PG8_SA(0, 0), a2, voffA);
            PG8_WAIT_V(8); PG8_WAIT_L(0); PG8_BAR; PG8_MMA(1, 0, At, B0); PG8_MMA(1, 1, At, B1); PG8_BAR; PG8_SCHED;
            PG8_LDB(B0, 1, 0); PG8_LDB(B1, 1, 1); PG8_SCHED; PG8_LDA(At, 1, 0); PG8_STAGE(PG8_SA(0, 1), a2 + hstepA, voffA);
            PG8_WAIT_V(8); PG8_WAIT_L(0); PG8_BAR; PG8_MMA(0, 0, At, B0); PG8_MMA(0, 1, At, B1); PG8_BAR; PG8_SCHED;
            PG8_LDA(At, 1, 1); PG8_STAGE(PG8_SB(1, 0), b3, voffB); PG8_STAGE(PG8_SB(1, 1), b3 + hstepB, voffB); PG8_STAGE(PG8_SA(1, 0), a3, voffA);
            PG8_WAIT_V(8); PG8_WAIT_L(0); PG8_BAR; PG8_MMA(1, 0, At, B0); PG8_MMA(1, 1, At, B1); PG8_BAR; PG8_SCHED;
        }
        if (wr == 0) PG8_BAR;
        E(acc, cur, wr, wc, fr, fq, lds + STAGE_BYTES);
        if (!has_next) break;
#pragma unroll
        for (int a = 0; a < 2; ++a)
#pragma unroll
            for (int b = 0; b < 2; ++b)
#pragma unroll
                for (int m = 0; m < 4; ++m)
#pragma unroll
                    for (int n = 0; n < 2; ++n) acc[a][b][m][n] = (f32x4){0.f, 0.f, 0.f, 0.f};
        cur = nxt; cA = nA; cB = nB; ++ui;
        if (wr == 1) PG8_BAR;
    }
    PG8_WAIT_V(0);
    PG8_BAR;
#undef PG8_APTR
#undef PG8_BPTR
#undef PG8_SA
#undef PG8_SB
#undef PG8_STAGE
#undef PG8_LDA
#undef PG8_LDB
#undef PG8_MMA
#undef PG8_WAIT_V
#undef PG8_WAIT_L
#undef PG8_BAR
#undef PG8_SCHED
}
}

namespace att {
constexpr int D = 128, NW = 8, QBLK = 32, KVBLK = 64;
constexpr float SCALE = 0.088388347648318440f;
constexpr float THR = 8.f;
constexpr int LDQ = NIN, LDK = NIN, LDO = DM;
constexpr size_t SHM_V = KVBLK * D * 2, SHM_K = KVBLK * D * 2, SHM_ATTN = 2 * SHM_V + 2 * SHM_K + NW * 64 * 4;
#define KSWZ(row, colB) ((row) * 256 + ((colB) ^ (((row) & 7) << 4)))
#define SBAR() __builtin_amdgcn_sched_barrier(0)
__device__ __forceinline__ int crow(int r, int hi) { return (r & 3) + 8 * (r >> 2) + 4 * hi; }
__device__ __forceinline__ unsigned cvtpk(float lo, float hi) { unsigned r; asm volatile("v_cvt_pk_bf16_f32 %0, %1, %2" : "=v"(r) : "v"(lo), "v"(hi)); return r; }

__device__ __forceinline__ void partialSM(f32x16& p0, f32x16& p1, float& m_reg, float& mn, float& alpha) {
  constexpr float C = SCALE * 1.4426950408889634f;
  float pmax = p0[0];
#pragma unroll
  for (int r = 1; r < 16; ++r) pmax = fmaxf(pmax, p0[r]);
#pragma unroll
  for (int r = 0; r < 16; ++r) pmax = fmaxf(pmax, p1[r]);
  { auto rr = __builtin_amdgcn_permlane32_swap(__float_as_uint(pmax), __float_as_uint(pmax), false, false);
    pmax = fmaxf(__uint_as_float(rr[0]), __uint_as_float(rr[1])); }
  if (__builtin_expect(__all(pmax - m_reg <= THR / SCALE), 1)) { mn = m_reg; alpha = 1.f; }
  else { mn = fmaxf(m_reg, pmax); alpha = __builtin_amdgcn_exp2f((m_reg - mn) * C); m_reg = mn; }
  float mnC = -mn * C;
#pragma unroll
  for (int r = 0; r < 16; ++r) p0[r] = fmaf(p0[r], C, mnC);
#pragma unroll
  for (int r = 0; r < 16; ++r) p1[r] = fmaf(p1[r], C, mnC);
#pragma unroll
  for (int r = 0; r < 16; ++r) p0[r] = __builtin_amdgcn_exp2f(p0[r]);
}
__device__ __forceinline__ void finishSM(f32x16& p0, f32x16& p1, float alpha, float& l_reg, bf16x8& pa0, bf16x8& pa1, bf16x8& pa2, bf16x8& pa3) {
#pragma unroll
  for (int r = 0; r < 16; ++r) p1[r] = __builtin_amdgcn_exp2f(p1[r]);
  float ps = 0;
#pragma unroll
  for (int r = 0; r < 16; ++r) ps += p0[r];
#pragma unroll
  for (int r = 0; r < 16; ++r) ps += p1[r];
  { auto rr = __builtin_amdgcn_permlane32_swap(__float_as_uint(ps), __float_as_uint(ps), false, false);
    ps = __uint_as_float(rr[0]) + __uint_as_float(rr[1]); }
  l_reg = l_reg * alpha + ps;
#define PK4(P, BASE, OUT) do { unsigned a0 = cvtpk(P[BASE + 0], P[BASE + 1]), a1 = cvtpk(P[BASE + 2], P[BASE + 3]);   \
    unsigned b0 = cvtpk(P[BASE + 4], P[BASE + 5]), b1 = cvtpk(P[BASE + 6], P[BASE + 7]);                              \
    auto r0 = __builtin_amdgcn_permlane32_swap(a0, b0, false, false); auto r1 = __builtin_amdgcn_permlane32_swap(a1, b1, false, false); \
    u32x4 w = {r0[0], r1[0], r0[1], r1[1]}; OUT = *reinterpret_cast<bf16x8*>(&w); } while (0)
  PK4(p0, 0, pa0); PK4(p0, 8, pa1); PK4(p1, 0, pa2); PK4(p1, 8, pa3);
#undef PK4
}
__device__ __forceinline__ void qkt(f32x16& p0, f32x16& p1, const bf16_t* Ks, const bf16x8* qr, int r32, int hi) {
  p0 = f32x16{}; p1 = f32x16{};
#pragma unroll
  for (int d0 = 0; d0 < 8; ++d0) { int cb = (d0 * 16 + hi * 8) * 2;
    bf16x8 b0 = *reinterpret_cast<const bf16x8*>((const char*)Ks + KSWZ(r32, cb));
    bf16x8 b1 = *reinterpret_cast<const bf16x8*>((const char*)Ks + KSWZ(32 + r32, cb));
    p0 = __builtin_amdgcn_mfma_f32_32x32x16_bf16(b0, qr[d0], p0, 0, 0, 0);
    p1 = __builtin_amdgcn_mfma_f32_32x32x16_bf16(b1, qr[d0], p1, 0, 0, 0); }
}
__device__ __forceinline__ int v_st(int k, int c) { const int kk = (k & ~0xC) | ((k & 4) << 1) | ((k & 8) >> 1); return ((kk >> 3) * 4 + (c >> 5)) * 512 + ((kk & 7) * 32 + (c & 31)) * 2; }
__device__ __forceinline__ int v_rd_base(int lane) { return ((lane & 3) << 3) | (((lane >> 2) & 3) << 6) | (((lane >> 4) & 1) << 5) | (((lane >> 5) & 1) << 8); }
constexpr int v_rd_off(int d0, int ks, int half) { return d0 * 512 + ks * 4096 + half * 2048; }
template <int OFF> __device__ __forceinline__ s16x4 tr_read(int vb) {
  s16x4 r; asm volatile("ds_read_b64_tr_b16 %0, %1 offset:%2" : "=&v"(r) : "v"(vb), "i"(OFF) : "memory"); return r;
}
template <int D0> __device__ __forceinline__ void pv_one(f32x16& od, int vb, bf16x8 pa0, bf16x8 pa1, bf16x8 pa2, bf16x8 pa3) {
  const s16x4 l0 = tr_read<v_rd_off(D0, 0, 0)>(vb), h0 = tr_read<v_rd_off(D0, 0, 1)>(vb), l1 = tr_read<v_rd_off(D0, 1, 0)>(vb), h1 = tr_read<v_rd_off(D0, 1, 1)>(vb);
  const s16x4 l2 = tr_read<v_rd_off(D0, 2, 0)>(vb), h2 = tr_read<v_rd_off(D0, 2, 1)>(vb), l3 = tr_read<v_rd_off(D0, 3, 0)>(vb), h3 = tr_read<v_rd_off(D0, 3, 1)>(vb);
  asm volatile("s_waitcnt lgkmcnt(0)" ::: "memory"); SBAR();
#define PK(L, H) (bf16x8){L[0], L[1], L[2], L[3], H[0], H[1], H[2], H[3]}
  od = __builtin_amdgcn_mfma_f32_32x32x16_bf16(pa0, PK(l0, h0), od, 0, 0, 0);
  od = __builtin_amdgcn_mfma_f32_32x32x16_bf16(pa1, PK(l1, h1), od, 0, 0, 0);
  od = __builtin_amdgcn_mfma_f32_32x32x16_bf16(pa2, PK(l2, h2), od, 0, 0, 0);
  od = __builtin_amdgcn_mfma_f32_32x32x16_bf16(pa3, PK(l3, h3), od, 0, 0, 0);
#undef PK
}
__device__ __forceinline__ void pv_d0(f32x16* o, int vb, bf16x8 pa0, bf16x8 pa1, bf16x8 pa2, bf16x8 pa3) {
  pv_one<0>(o[0], vb, pa0, pa1, pa2, pa3); pv_one<1>(o[1], vb, pa0, pa1, pa2, pa3); pv_one<2>(o[2], vb, pa0, pa1, pa2, pa3); pv_one<3>(o[3], vb, pa0, pa1, pa2, pa3);
}

__device__ __forceinline__ void attn_dense_body(const bf16_t* __restrict__ Qb, const bf16_t* __restrict__ Kh, const bf16_t* __restrict__ Vh,
                                                bf16_t* __restrict__ Ob, int seq, char* lds) {
  const int tid = threadIdx.x, wid = tid >> 6, lane = tid & 63, r32 = lane & 31, hi = lane >> 5;
  bf16_t* V_lds = (bf16_t*)lds; bf16_t* K_lds = (bf16_t*)(lds + 2 * SHM_V);
  float* ws = (float*)(lds + 2 * SHM_V + 2 * SHM_K) + wid * 64; float* li_l = ws; float* al_l = ws + 32;
  float m_reg = -1e30f, l_reg = 0; f32x16 o[4] = {}; bf16x8 qr[8];
  const bf16_t* Qw = Qb + (long)(wid * QBLK + r32) * LDQ + hi * 8;
#pragma unroll
  for (int d0 = 0; d0 < 8; ++d0) qr[d0] = *reinterpret_cast<const bf16x8*>(Qw + d0 * 16);
  const int sr = tid >> 4, sc = (tid & 15) * 8, vst0 = v_st(sr, sc), vst1 = v_st(32 + sr, sc);
  const int vb0 = (int)(uintptr_t)V_lds + v_rd_base(lane);
  struct { bf16x8 vs0, vs1, ks0, ks1; } sr_[2];
#define SLOAD(i, k0) do { sr_[i].vs0 = *reinterpret_cast<const bf16x8*>(&Vh[(long)((k0) + sr) * LDK + sc]); sr_[i].vs1 = *reinterpret_cast<const bf16x8*>(&Vh[(long)((k0) + 32 + sr) * LDK + sc]); \
    sr_[i].ks0 = *reinterpret_cast<const bf16x8*>(&Kh[(long)((k0) + sr) * LDK + sc]); sr_[i].ks1 = *reinterpret_cast<const bf16x8*>(&Kh[(long)((k0) + 32 + sr) * LDK + sc]); } while (0)
#define SWRITE(b, i) do { *(bf16x8*)((char*)V_lds + (b) * SHM_V + vst0) = sr_[i].vs0;          \
    *(bf16x8*)((char*)V_lds + (b) * SHM_V + vst1) = sr_[i].vs1; int kc = sc * 2;               \
    *(bf16x8*)((char*)K_lds + (b) * SHM_K + KSWZ(sr, kc)) = sr_[i].ks0;                       \
    *(bf16x8*)((char*)K_lds + (b) * SHM_K + KSWZ(32 + sr, kc)) = sr_[i].ks1; } while (0)
#define SWAIT() asm volatile("s_waitcnt vmcnt(4)" ::: "memory")
#define RESC(a) do { if (__any((a) < 1.f)) { if (hi == 0) al_l[r32] = (a); asm volatile("s_waitcnt lgkmcnt(0)" ::: "memory"); \
    _Pragma("unroll") for (int d = 0; d < 4; ++d) _Pragma("unroll") for (int r = 0; r < 16; ++r) o[d][r] *= al_l[crow(r, hi)]; } } while (0)
  f32x16 pA0, pA1, pB0, pB1; float mnA, mnB, alA, alB; bf16x8 pa0, pa1, pa2, pa3; const int NT = seq / KVBLK;
  constexpr int SE = 0, SO = 1;
  SLOAD(SE, 0); asm volatile("s_waitcnt vmcnt(0)" ::: "memory"); SWRITE(0, SE); __syncthreads();
  qkt(pA0, pA1, K_lds, qr, r32, hi); partialSM(pA0, pA1, m_reg, mnA, alA);
  SLOAD(SO, KVBLK); if (2 < NT) SLOAD(SE, 2 * KVBLK);
  SWAIT(); SWRITE(1, SO); __syncthreads();
  for (int j = 1; j + 1 < NT; j += 2) {
    SBAR(); qkt(pB0, pB1, (bf16_t*)((char*)K_lds + SHM_K), qr, r32, hi);
    finishSM(pA0, pA1, alA, l_reg, pa0, pa1, pa2, pa3); SBAR();
    SLOAD(SO, (j + 2) * KVBLK); SBAR();
    pv_d0(o, vb0, pa0, pa1, pa2, pa3); partialSM(pB0, pB1, m_reg, mnB, alB);
    __syncthreads(); SWAIT(); SWRITE(0, SE);
    RESC(alB); __syncthreads();
    SBAR(); qkt(pA0, pA1, K_lds, qr, r32, hi);
    finishSM(pB0, pB1, alB, l_reg, pa0, pa1, pa2, pa3); SBAR();
    if (j + 3 < NT) SLOAD(SE, (j + 3) * KVBLK); SBAR();
    pv_d0(o, vb0 + (int)SHM_V, pa0, pa1, pa2, pa3); partialSM(pA0, pA1, m_reg, mnA, alA);
    __syncthreads(); SWAIT(); SWRITE(1, SO);
    RESC(alA); __syncthreads();
  }
  SBAR(); qkt(pB0, pB1, (bf16_t*)((char*)K_lds + SHM_K), qr, r32, hi);
  finishSM(pA0, pA1, alA, l_reg, pa0, pa1, pa2, pa3); SBAR();
  pv_d0(o, vb0, pa0, pa1, pa2, pa3); partialSM(pB0, pB1, m_reg, mnB, alB);
  __syncthreads(); RESC(alB);
  finishSM(pB0, pB1, alB, l_reg, pa0, pa1, pa2, pa3); SBAR();
  pv_d0(o, vb0 + (int)SHM_V, pa0, pa1, pa2, pa3);
  if (hi == 0) li_l[r32] = l_reg; asm volatile("s_waitcnt lgkmcnt(0)" ::: "memory");
  float rli[16];
#pragma unroll
  for (int r = 0; r < 16; ++r) rli[r] = __builtin_amdgcn_rcpf(li_l[crow(r, hi)]);
  bf16_t* Ow = Ob + (long)(wid * QBLK) * LDO;
#pragma unroll
  for (int r = 0; r < 16; ++r) { int orow = crow(r, hi);
#pragma unroll
    for (int d0 = 0; d0 < 4; ++d0) Ow[(long)orow * LDO + d0 * 32 + r32] = (bf16_t)f2bf(o[d0][r] * rli[r]); }
  __syncthreads();
#undef SLOAD
#undef SWRITE
#undef SWAIT
#undef RESC
}
}

#define XB_TMO      128
#define XB_XCNT(j)  (256  + 64 * (j))
#define XB_XSUB(j)  (1280 + 64 * (j))
#define XB_XGEN(j)  (2304 + 64 * (j))
#define XB_TOP      3328
#define XB_TOPGEN   3392
#define XCD_BAR_WORDS 3456
#define XB_SPIN_CAP (1u << 18)
static_assert(XCD_BAR_WORDS * 4 <= 16384, "barrier words");
__device__ __forceinline__ unsigned xb_ld(unsigned* p)              { return __hip_atomic_load(p, __ATOMIC_RELAXED, __HIP_MEMORY_SCOPE_AGENT); }
__device__ __forceinline__ unsigned xb_add(unsigned* p, unsigned v) { return __hip_atomic_fetch_add(p, v, __ATOMIC_RELAXED, __HIP_MEMORY_SCOPE_AGENT); }
__device__ __forceinline__ unsigned xb_xcc_id() { return (unsigned)__builtin_amdgcn_s_getreg((3 << 11) | 20) & 0xFu; }
#define XB_SPIN(cond, bar) do { unsigned _sp = 0; while (cond) { __builtin_amdgcn_s_sleep(1); \
    if ((++_sp & 255u) == 0u) { if (xb_ld(&(bar)[XB_TMO])) break; if (_sp > XB_SPIN_CAP) { atomicAdd(&(bar)[XB_TMO], 1u); break; } } } } while (0)
struct XcdBarrier { unsigned* bar; unsigned x; volatile LAS unsigned* st; };
__device__ __forceinline__ XcdBarrier xcd_barrier_post(unsigned* bar, volatile LAS unsigned* st) {
    XcdBarrier b; b.bar = bar; b.x = xb_xcc_id(); b.st = st;
    if (threadIdx.x == 0) (void)xb_add(&bar[XB_XCNT(b.x)], 1u);
    return b;
}
__device__ __forceinline__ void xcd_barrier_complete(unsigned* bar, unsigned x, unsigned& nloc, unsigned& nx) {
    const unsigned G = gridDim.x * gridDim.y * gridDim.z;
    unsigned sum, cnt, mine, sp = 0u;
    for (;;) {
        sum = 0u; cnt = 0u; mine = 0u;
#pragma unroll
        for (unsigned j = 0; j < 16; ++j) { const unsigned c = xb_ld(&bar[XB_XCNT(j)]); sum += c; cnt += (c > 0u) ? 1u : 0u; mine = (j == x) ? c : mine; }
        if (sum == G) break;
        __builtin_amdgcn_s_sleep(1);
        if ((++sp & 255u) == 0u) { if (xb_ld(&bar[XB_TMO])) break; if (sp > XB_SPIN_CAP) { atomicAdd(&bar[XB_TMO], 1u); break; } }
    }
    nloc = mine > 0u ? mine : 1u; nx = cnt > 0u ? cnt : 1u;
}
__device__ __forceinline__ void xcd_barrier(const XcdBarrier& b) {
    asm volatile("s_waitcnt vmcnt(0)" ::: "memory");
    __syncthreads();
    if (threadIdx.x == 0) {
        unsigned* bar = b.bar;
        __builtin_amdgcn_s_waitcnt(0);
        unsigned nloc = b.st[0], nx = b.st[1];
        if (nloc == 0u) { xcd_barrier_complete(bar, b.x, nloc, nx); b.st[0] = nloc; b.st[1] = nx; }
        const unsigned old = xb_add(&bar[XB_XSUB(b.x)], 1u);
        const unsigned gen = old / nloc;
        if (old + 1u == (gen + 1u) * nloc) {
            __builtin_amdgcn_fence(__ATOMIC_RELEASE, "agent");
            asm volatile("s_waitcnt vmcnt(0)" ::: "memory");
            const unsigned og = xb_add(&bar[XB_TOP], 1u);
            const unsigned tg = og / nx;
            if (og + 1u == (tg + 1u) * nx) xb_add(&bar[XB_TOPGEN], 1u);
            else XB_SPIN(xb_ld(&bar[XB_TOPGEN]) == tg, bar);
            __builtin_amdgcn_fence(__ATOMIC_ACQUIRE, "agent");
            xb_add(&bar[XB_XGEN(b.x)], 1u);
            asm volatile("s_waitcnt vmcnt(0)" ::: "memory");
        } else {
            XB_SPIN(xb_ld(&bar[XB_XGEN(b.x)]) == gen, bar);
            __builtin_amdgcn_fence(__ATOMIC_ACQUIRE, "agent");
            asm volatile("s_waitcnt vmcnt(0)" ::: "memory");
        }
    }
    __syncthreads();
}

struct Args { const float* in[19]; float* out; unsigned char* ws; int ph_lo, ph_hi; };
enum { I_X = 0, I_C, I_CTX, I_CCTX, I_MODW, I_MODB, I_N1G, I_N2G, I_WIN, I_WOUT, I_QG, I_KG, I_RPB, I_FW, I_WUP, I_CW, I_CB, I_WDN, I_FG };

__device__ __forceinline__ s16x4 vtr(const LAS unsigned char* p) { return __builtin_bit_cast(s16x4, __builtin_amdgcn_ds_read_tr16_b64_v4i16((LAS v4i16_t*)p)); }

__device__ __forceinline__ int up_perm(int n) { return n < FF ? ((n >> 7) * 256 + (n & 127)) : ((((n - FF) >> 7) * 256) + 128 + ((n - FF) & 127)); }

__device__ __forceinline__ void transpose_tile(const float* __restrict__ W, int N, bf16_t* __restrict__ WT, int ldt, int tk, int tn, bool perm, LAS float* scr) {
    const int tid = threadIdx.x;
#pragma unroll
    for (int i = 0; i < 8; ++i) { const int kk = (tid >> 6) + 8 * i, nn = tid & 63; scr[kk * 65 + nn] = W[(size_t)(tk * 64 + kk) * N + tn * 64 + nn]; }
    __syncthreads();
    { const int nn = tid >> 3, kc = tid & 7; float v[8];
#pragma unroll
      for (int e = 0; e < 8; ++e) v[e] = scr[(kc * 8 + e) * 65 + nn];
      const int n = tn * 64 + nn, nrow = perm ? up_perm(n) : n;
      u32x4 w; w.x = pk2(v[0], v[1]); w.y = pk2(v[2], v[3]); w.z = pk2(v[4], v[5]); w.w = pk2(v[6], v[7]);
      *(u32x4*)(WT + (size_t)nrow * ldt + tk * 64 + kc * 8) = w; }
    __syncthreads();
}

__device__ __forceinline__ void adaln_item(const Args& a, int item, float* MOD, LAS float* sv, LAS float* red) {
    const int tid = threadIdx.x, l = item / 96, j = item % 96;
    const float* c = a.in[I_C]; const float* cc = a.in[I_CCTX];
    for (int idx = tid; idx < 5 * 1024; idx += 512) { const int r = idx >> 10, k = idx & 1023; const float v = r < 4 ? c[r * 1024 + k] : cc[k]; sv[idx] = v / (1.f + __expf(-v)); }
    __syncthreads();
    const int col = tid & 63, kg = tid >> 6;
    const float* w = a.in[I_MODW] + (size_t)l * 1024 * 6144 + j * 64 + col;
    float acc[5] = {0.f, 0.f, 0.f, 0.f, 0.f};
    for (int k = kg * 128; k < kg * 128 + 128; ++k) { const float wv = w[(size_t)k * 6144];
#pragma unroll
        for (int r = 0; r < 5; ++r) acc[r] += sv[r * 1024 + k] * wv; }
#pragma unroll
    for (int r = 0; r < 5; ++r) red[(kg * 5 + r) * 64 + col] = acc[r];
    __syncthreads();
    if (tid < 320) { const int r = tid >> 6, cl = tid & 63; float s = 0.f;
#pragma unroll
        for (int g = 0; g < 8; ++g) s += red[(g * 5 + r) * 64 + cl];
        MOD[(size_t)(l * 5 + r) * 6144 + j * 64 + cl] = s + a.in[I_MODB][l * 6144 + j * 64 + cl]; }
    __syncthreads();
}

__device__ __forceinline__ void p0_prologue(const Args& a, LAS unsigned char* lds, int G, int bx) {
    unsigned char* ws = a.ws;
    const int tid = threadIdx.x;
    {
        const long gt = (long)bx * 512 + tid, GT = (long)G * 512;
        bf16_t* dftc = (bf16_t*)(ws + WS_DFTC);
        for (long i = gt; i < 512 * 256; i += GT) { const int row = (int)(i >> 8), n = (int)(i & 255), ri = row >> 8, m = row & 255; float s, c; sincospif((float)((m * n) & 255) * (1.f / 128.f), &s, &c); dftc[i] = (bf16_t)f2bf(ri ? -s : c); }
        bf16_t* f1 = (bf16_t*)(ws + WS_F1);
        for (long i = gt; i < 128 * 128; i += GT) { const int row = (int)(i >> 7), col = (int)(i & 127), ro = row >> 6, k1 = row & 63, ri = col >> 6, t1 = col & 63; float s, c; sincospif((float)((k1 * t1) & 63) * (1.f / 32.f), &s, &c);
            const float v = (ro == 0) ? (ri == 0 ? c : s) : (ri == 0 ? -s : c); f1[i] = (bf16_t)f2bf(v); }
        bf16_t* f2 = (bf16_t*)(ws + WS_F2);
        for (long i = gt; i < 64 * 128; i += GT) { const int k2 = (int)(i >> 7), col = (int)(i & 127), ri = col >> 6, t2 = col & 63; float s, c; sincospif((float)((k2 * t2) & 63) * (1.f / 32.f), &s, &c); f2[i] = (bf16_t)f2bf(ri == 0 ? c : s); }
        float2* tw = (float2*)(ws + WS_TW);
        for (long i = gt; i < 4096; i += GT) { float s, c; sincospif((float)i * (1.f / 2048.f), &s, &c); tw[i] = make_float2(c, s); }
        float2* rope = (float2*)(ws + WS_ROPE);
        for (long i = gt; i < 64 * 32; i += GT) { const int pos = (int)(i >> 5), j = (int)(i & 31); const float fr = powf(10000.f, -(float)j / 32.f); const float ang = (float)pos * fr; rope[i] = make_float2(cosf(ang), sinf(ang)); }
    }
    LAS float* scr = (LAS float*)lds;
    for (int it = bx; it < 192; it += G) adaln_item(a, it, (float*)(ws + WS_MOD), scr, scr + 5 * 1024);
    for (int t = bx; t < 5376; t += G) {
        if (t < 640) transpose_tile(a.in[I_WIN], NIN, (bf16_t*)(ws + WS_WIN), DM, t / 40, t % 40, false, scr);
        else if (t < 896) { const int u = t - 640; transpose_tile(a.in[I_WOUT], DM, (bf16_t*)(ws + WS_WO), DM, u / 16, u % 16, false, scr); }
        else if (t < 1152) { const int u = t - 896; transpose_tile(a.in[I_FW], DM, (bf16_t*)(ws + WS_WF), DM, u / 16, u % 16, false, scr); }
        else if (t < 3968) { const int u = t - 1152, l = u / 1408, v = u % 1408; transpose_tile(a.in[I_WUP] + (size_t)l * DM * NUP, NUP, (bf16_t*)(ws + WS_WUP) + (size_t)l * NUP * DM, DM, v / 88, v % 88, true, scr); }
        else { const int u = t - 3968, l = u / 704, v = u % 704; transpose_tile(a.in[I_WDN] + (size_t)l * FF * DM, DM, (bf16_t*)(ws + WS_WDN) + (size_t)l * DM * FF, FF, v / 16, v % 16, false, scr); }
    }
}

__device__ __forceinline__ void norm_mod_phase(const float* __restrict__ xl, const float* __restrict__ xc, bool with_ctx, const float* __restrict__ gain,
                                               const float* __restrict__ MODl, int chunk, bf16_t* __restrict__ out, int G, int bx) {
    const int wid = threadIdx.x >> 6, lane = threadIdx.x & 63;
    const int nrows = with_ctx ? MQ : ML;
    for (int row = bx * 8 + wid; row < nrows; row += G * 8) {
        int b, t; if (with_ctx) { b = row / LT; t = row - b * LT; } else { b = row >> 12; t = row & 4095; }
        const float* src = (t < LSEQ) ? xl + ((size_t)b * LSEQ + t) * DM : xc + ((size_t)b * CTXL + (t - LSEQ)) * DM;
        const float* mrow = MODl + (size_t)((t < LSEQ) ? b : 4) * 6144 + chunk * 1024;
        f32x4 v[4]; float ss = 0.f;
#pragma unroll
        for (int j = 0; j < 4; ++j) { v[j] = *(const f32x4*)(src + j * 256 + lane * 4); ss += v[j][0] * v[j][0] + v[j][1] * v[j][1] + v[j][2] * v[j][2] + v[j][3] * v[j][3]; }
        ss = wave_sum(ss);
        const float rstd = rsqrtf(ss * (1.f / 1024.f) + EPS);
#pragma unroll
        for (int j = 0; j < 4; ++j) { const int c = j * 256 + lane * 4;
            const f32x4 g = *(const f32x4*)(gain + c), sh = *(const f32x4*)(mrow + c), sc = *(const f32x4*)(mrow + 1024 + c);
            const f32x4 y = (v[j] * rstd * g) * (sc + 1.f) + sh;
            u32x2 w; w.x = pk2(y[0], y[1]); w.y = pk2(y[2], y[3]);
            *(u32x2*)(out + (size_t)row * DM + c) = w; }
    }
}

__device__ __forceinline__ void final_norm_phase(float* __restrict__ x, const float* __restrict__ gain, int G, int bx) {
    const int wid = threadIdx.x >> 6, lane = threadIdx.x & 63;
    for (int row = bx * 8 + wid; row < ML; row += G * 8) {
        float* src = x + (size_t)row * DM;
        f32x4 v[4]; float ss = 0.f;
#pragma unroll
        for (int j = 0; j < 4; ++j) { v[j] = *(const f32x4*)(src + j * 256 + lane * 4); ss += v[j][0] * v[j][0] + v[j][1] * v[j][1] + v[j][2] * v[j][2] + v[j][3] * v[j][3]; }
        ss = wave_sum(ss);
        const float rstd = rsqrtf(ss * (1.f / 1024.f) + EPS);
#pragma unroll
        for (int j = 0; j < 4; ++j) { const int c = j * 256 + lane * 4; const f32x4 g = *(const f32x4*)(gain + c); *(f32x4*)(src + c) = v[j] * rstd * g; }
    }
}

__device__ __forceinline__ void qknorm_phase(bf16_t* __restrict__ QKV, const float* __restrict__ qg, const float* __restrict__ kg, const float2* __restrict__ rope, int G, int bx) {
    const int wid = threadIdx.x >> 6, lane = threadIdx.x & 63;
    const long total = (long)MQ * 6;
    for (long wi = (long)bx * 8 + wid; wi < total; wi += (long)G * 8) {
        const int row = (int)(wi / 6), slot = (int)(wi - (long)row * 6);
        const int b = row / LT, t = row - b * LT;
        const bool isctx = t >= LSEQ;
        if (isctx && slot < 4) continue;
        const int col0 = slot < 4 ? slot * 128 : 1024 + (slot - 4) * 128;
        const float* gw = slot < 4 ? qg : kg;
        unsigned* p = (unsigned*)(QKV + (size_t)row * NIN + col0) + lane;
        const unsigned raw = *p;
        float x0 = bf2f(raw & 0xffffu), x1 = bf2f(raw >> 16);
        const float ss = wave_sum(x0 * x0 + x1 * x1);
        const float rstd = rsqrtf(ss * (1.f / 128.f) + EPS);
        x0 = x0 * rstd * gw[2 * lane]; x1 = x1 * rstd * gw[2 * lane + 1];
        if (!isctx) {
            const int pos = lane < 32 ? (t >> 6) : (t & 63);
            const float2 cs = rope[pos * 32 + (lane & 31)];
            const float y0 = x0 * cs.x - x1 * cs.y, y1 = x0 * cs.y + x1 * cs.x; x0 = y0; x1 = y1;
        }
        *p = pk2(x0, x1);
    }
}

constexpr int NA_PITCH = 144, NA_SLOT = 64 * NA_PITCH;
constexpr int NA_CTXV = 8 * NA_SLOT;
constexpr int NA_MB = NA_CTXV + 256 * NA_PITCH;
constexpr int NA_RPB = NA_MB + 4 * 64 * 18 * 4;
static_assert(NA_RPB + 15 * 31 * 4 <= LDS_BYTES - 16, "NA LDS map");
__device__ __forceinline__ void na_block(const bf16_t* __restrict__ QKV, const float* __restrict__ rpb, bf16_t* __restrict__ MIX, int b, int hb, int r_begin, int r_end, LAS unsigned char* lds) {
    const int tid = threadIdx.x, wid = __builtin_amdgcn_readfirstlane(tid >> 6), lane = tid & 63, n = lane & 15, kq = lane >> 4;
    const int qg = wid & 3, kh = wid >> 2;
    const int c0 = qg * 16, kc0 = (qg == 0) ? 0 : (qg == 1) ? 8 : (qg == 2) ? 24 : 32;
    const bf16_t* base = QKV + (size_t)b * LT * NIN;
    const bf16_t* vbase = base + 2048 + hb * 64;
    LAS float* rp = (LAS float*)(lds + NA_RPB);
    int r0p = min(max(r_begin - 4, 0), 56);
    {
        for (int i = tid; i < 15 * 31; i += 512) rp[i] = rpb[hb * 15 * 31 + i];
#pragma unroll
        for (int i = 0; i < 4; ++i) { const int cid = tid + 512 * i, tok = cid >> 3, cc = cid & 7;
            *(LAS u32x4*)(lds + NA_CTXV + tok * NA_PITCH + cc * 16) = *(const u32x4*)(vbase + (size_t)(LSEQ + tok) * NIN + cc * 8); }
#pragma unroll
        for (int i = 0; i < 8; ++i) { const int cid = tid + 512 * i, row = cid >> 9, tok = (cid >> 3) & 63, cc = cid & 7, gr = r0p + row;
            *(LAS u32x4*)(lds + (gr & 7) * NA_SLOT + tok * NA_PITCH + cc * 16) = *(const u32x4*)(vbase + (size_t)(gr * 64 + tok) * NIN + cc * 8); }
    }
    __syncthreads();
    for (int r = r_begin; r < r_end; ++r) {
        const int r0 = min(max(r - 4, 0), 56);
        const bool newrow = (r0 != r0p);
        u32x4 nvv = {0u, 0u, 0u, 0u};
        if (newrow) nvv = *(const u32x4*)(vbase + (size_t)((r0 + 7) * 64 + (tid >> 3)) * NIN + (tid & 7) * 8);
        const bf16_t* qp = base + (size_t)(r * 64 + c0 + n) * NIN + 512 + hb * 64 + 8 * kq;
        const bf16x8 qf0 = *(const bf16x8*)qp, qf1 = *(const bf16x8*)(qp + 32);
        f32x4 s[16];
#pragma unroll
        for (int kb = 0; kb < 16; ++kb) {
            const int tok = kh == 0 ? ((r0 + (kb >> 1)) * 64 + kc0 + 16 * (kb & 1) + n) : (LSEQ + 16 * kb + n);
            const bf16_t* kp = base + (size_t)tok * NIN + 1536 + hb * 64 + 8 * kq;
            const bf16x8 a0 = *(const bf16x8*)kp, a1 = *(const bf16x8*)(kp + 32);
            f32x4 acc = {0.f, 0.f, 0.f, 0.f};
            acc = __builtin_amdgcn_mfma_f32_16x16x32_bf16(a0, qf0, acc, 0, 0, 0);
            acc = __builtin_amdgcn_mfma_f32_16x16x32_bf16(a1, qf1, acc, 0, 0, 0);
            s[kb] = acc;
        }
        float mx = -1e30f;
        if (kh == 0) {
            const int c = c0 + n, cs = min(max(c - 8, 0), 48);
#pragma unroll
            for (int kb = 0; kb < 16; ++kb) { const int i = kb >> 1, ro = r0 + i - r + 7;
#pragma unroll
                for (int j = 0; j < 4; ++j) { const int kc = kc0 + 16 * (kb & 1) + 4 * kq + j; const bool valid = (kc >= cs) && (kc < cs + 16);
                    const int co = min(max(kc - c + 15, 0), 30);
                    const float bias = rp[ro * 31 + co];
                    const float v = valid ? s[kb][j] * 0.125f + bias : -1e30f; s[kb][j] = v; mx = fmaxf(mx, v); } }
        } else {
#pragma unroll
            for (int kb = 0; kb < 16; ++kb)
#pragma unroll
                for (int j = 0; j < 4; ++j) { const float v = s[kb][j] * 0.125f; s[kb][j] = v; mx = fmaxf(mx, v); }
        }
        mx = fmaxf(mx, __shfl_xor(mx, 16)); mx = fmaxf(mx, __shfl_xor(mx, 32));
        float lsum = 0.f;
#pragma unroll
        for (int kb = 0; kb < 16; ++kb)
#pragma unroll
            for (int j = 0; j < 4; ++j) { const float p = __builtin_amdgcn_exp2f((s[kb][j] - mx) * 1.4426950408889634f); s[kb][j] = p; lsum += p; }
        lsum += __shfl_xor(lsum, 16); lsum += __shfl_xor(lsum, 32);
        if (newrow) *(LAS u32x4*)(lds + ((r0 + 7) & 7) * NA_SLOT + (tid >> 3) * NA_PITCH + (tid & 7) * 16) = nvv;
        __syncthreads();
        f32x4 o[4];
#pragma unroll
        for (int d = 0; d < 4; ++d) o[d] = (f32x4){0.f, 0.f, 0.f, 0.f};
        const int lane_off = (4 * kq + (n >> 2)) * NA_PITCH + (n & 3) * 8;
#pragma unroll
        for (int t = 0; t < 8; ++t) {
            const LAS unsigned char* trp = lds + (kh == 0 ? (((r0 + t) & 7) * NA_SLOT + kc0 * NA_PITCH) : (NA_CTXV + 32 * t * NA_PITCH)) + lane_off;
            u32x4 bw; bw.x = cvt_pk_bf16(s[2 * t][0], s[2 * t][1]); bw.y = cvt_pk_bf16(s[2 * t][2], s[2 * t][3]); bw.z = cvt_pk_bf16(s[2 * t + 1][0], s[2 * t + 1][1]); bw.w = cvt_pk_bf16(s[2 * t + 1][2], s[2 * t + 1][3]);
            const bf16x8 bfr = __builtin_bit_cast(bf16x8, bw);
#pragma unroll
            for (int d = 0; d < 4; ++d) {
                const s16x4 lo = vtr(trp + d * 32), hi = vtr(trp + 16 * NA_PITCH + d * 32);
                const bf16x8 afr = (bf16x8){lo[0], lo[1], lo[2], lo[3], hi[0], hi[1], hi[2], hi[3]};
                o[d] = __builtin_amdgcn_mfma_f32_16x16x32_bf16(afr, bfr, o[d], 0, 0, 0);
            }
        }
        LAS float* mb = (LAS float*)(lds + NA_MB) + (qg * 64 + lane) * 18;
        if (kh == 1) { mb[0] = mx; mb[1] = lsum;
#pragma unroll
            for (int d = 0; d < 4; ++d)
#pragma unroll
                for (int j = 0; j < 4; ++j) mb[2 + d * 4 + j] = o[d][j]; }
        __syncthreads();
        if (kh == 0) {
            const float m1 = mb[0], l1 = mb[1];
            const float m = fmaxf(mx, m1), e0 = __builtin_amdgcn_exp2f((mx - m) * 1.4426950408889634f), e1 = __builtin_amdgcn_exp2f((m1 - m) * 1.4426950408889634f);
            const float inv = 1.f / (lsum * e0 + l1 * e1);
            bf16_t* op = MIX + (size_t)(b * LSEQ + r * 64 + c0 + n) * DM + 512 + hb * 64 + 4 * kq;
#pragma unroll
            for (int d = 0; d < 4; ++d) { float y[4];
#pragma unroll
                for (int j = 0; j < 4; ++j) y[j] = (o[d][j] * e0 + mb[2 + d * 4 + j] * e1) * inv;
                u32x2 w; w.x = pk2(y[0], y[1]); w.y = pk2(y[2], y[3]);
                *(u32x2*)(op + d * 16) = w; }
        }
        __syncthreads();
        r0p = r0;
    }
}

__device__ __forceinline__ void attention_phase(const bf16_t* __restrict__ QKV, const float* __restrict__ rpb, bf16_t* __restrict__ MIX, unsigned char* lds_g, LAS unsigned char* lds, int G, int vcu) {
    if (SEC(4)) for (int it = vcu; it < 256; it += G) {
        const int combo = it >> 5, w = it & 31, b = combo >> 1, kvh = combo & 1, g = w >> 4, qb = w & 15, h = kvh * 2 + g;
        const bf16_t* base = QKV + (size_t)b * LT * NIN;
        att::attn_dense_body(base + (size_t)(qb * 256) * NIN + h * 128, base + 1024 + kvh * 128, base + 1280 + kvh * 128,
                             MIX + (size_t)(b * LSEQ + qb * 256) * DM + h * 128, LT, (char*)lds_g);
    }
    const int per = (2048 + G - 1) / G;
    if (SEC(5)) { int it = vcu * per; const int end = min(2048, (vcu + 1) * per);
        while (it < end) { const int combo = it >> 6, seg_end = min(end, (combo + 1) * 64), r_begin = it & 63;
            na_block(QKV, rpb, MIX, combo >> 3, combo & 7, r_begin, r_begin + (seg_end - it), lds); it = seg_end; } }
}

__device__ __forceinline__ void convgate_phase(const bf16_t* __restrict__ U, bf16_t* __restrict__ ACT, const float* __restrict__ cw, const float* __restrict__ cb, int chunk, int G, int bx) {
    constexpr int RCH = 8, NCV = FF / 8;
    const long total = (long)(CHROWS / RCH) * NCV;
    for (long idx = (long)bx * 512 + threadIdx.x; idx < total; idx += (long)G * 512) {
        const int cv = (int)(idx % NCV), rc = (int)(idx / NCV);
        const int c = cv * 8, np = (c >> 7) * 256 + (c & 127);
        const int t0 = rc * RCH;
        float wg[3][8], wv[3][8], bg[8], bv[8];
#pragma unroll
        for (int j = 0; j < 3; ++j)
#pragma unroll
            for (int e = 0; e < 8; ++e) { wg[j][e] = cw[j * NUP + c + e]; wv[j][e] = cw[j * NUP + FF + c + e]; }
#pragma unroll
        for (int e = 0; e < 8; ++e) { bg[e] = cb[c + e]; bv[e] = cb[FF + c + e]; }
        float pg[8], pv[8], cg_[8], cv_[8], ng[8], nv[8];
        auto ld = [&](int t, float* g8, float* v8) {
            if (t < 0 || t >= CHROWS || ((t >> 12) != (t0 >> 12))) {
#pragma unroll
                for (int e = 0; e < 8; ++e) { g8[e] = 0.f; v8[e] = 0.f; }
            } else {
                const u32x4 a = *(const u32x4*)(U + (size_t)t * NUP + np), bq = *(const u32x4*)(U + (size_t)t * NUP + np + 128);
#pragma unroll
                for (int e = 0; e < 4; ++e) { g8[2 * e] = bf2f(a[e] & 0xffffu); g8[2 * e + 1] = bf2f(a[e] >> 16); v8[2 * e] = bf2f(bq[e] & 0xffffu); v8[2 * e + 1] = bf2f(bq[e] >> 16); }
            }
        };
        ld(t0 - 1, pg, pv); ld(t0, cg_, cv_);
#pragma unroll
        for (int i = 0; i < RCH; ++i) {
            ld(t0 + i + 1, ng, nv);
            float y[8];
#pragma unroll
            for (int e = 0; e < 8; ++e) {
                const float gg = pg[e] * wg[0][e] + cg_[e] * wg[1][e] + ng[e] * wg[2][e] + bg[e];
                const float vv = pv[e] * wv[0][e] + cv_[e] * wv[1][e] + nv[e] * wv[2][e] + bv[e];
                y[e] = gg / (1.f + __expf(-gg)) * vv;
            }
            u32x4 w; w.x = pk2(y[0], y[1]); w.y = pk2(y[2], y[3]); w.z = pk2(y[4], y[5]); w.w = pk2(y[6], y[7]);
            *(u32x4*)(ACT + ((size_t)chunk * CHROWS + t0 + i) * FF + c) = w;
#pragma unroll
            for (int e = 0; e < 8; ++e) { pg[e] = cg_[e]; pv[e] = cv_[e]; cg_[e] = ng[e]; cv_[e] = nv[e]; }
        }
    }
}

template <int STAGE>
__device__ __forceinline__ void fft_phase(const bf16_t* __restrict__ IN, bf16_t* __restrict__ OUT, const bf16_t* __restrict__ F, const float2* __restrict__ TW, LAS unsigned char* lds, int G, int bx) {
    constexpr int MB = STAGE == 1 ? 8 : 4, PITCH = 528;
    const int tid = threadIdx.x, wid = __builtin_amdgcn_readfirstlane(tid >> 6), lane = tid & 63, n = lane & 15, kq = lane >> 4;
    for (int it = bx; it < 1024; it += G) {
        const int g = it & 3, t = (it >> 2) & 63, b = it >> 8;
#pragma unroll
        for (int i = 0; i < 8; ++i) { const int cid = tid + 512 * i, row = cid >> 5, cc = cid & 31, ri = row >> 6, tt = row & 63;
            const size_t srow = STAGE == 1 ? ((size_t)b * 4096 + tt * 64 + t) : (((size_t)b * 64 + t) * 64 + tt);
            const u32x4 v = *(const u32x4*)(IN + srow * 2048 + g * 512 + ri * 256 + cc * 8);
            *(LAS u32x4*)(lds + row * PITCH + cc * 16) = v; }
        __syncthreads();
        f32x4 acc[MB][2];
#pragma unroll
        for (int mb = 0; mb < MB; ++mb) { acc[mb][0] = (f32x4){0.f, 0.f, 0.f, 0.f}; acc[mb][1] = (f32x4){0.f, 0.f, 0.f, 0.f}; }
#pragma unroll 1
        for (int ks = 0; ks < 4; ++ks) {
            bf16x8 bfr[2];
#pragma unroll
            for (int j = 0; j < 2; ++j) { const int nb = 2 * wid + j;
                const LAS unsigned char* p = lds + (ks * 32 + 8 * kq + (n >> 2)) * PITCH + (nb * 16 + 4 * (n & 3)) * 2;
                const s16x4 lo = vtr(p), hi = vtr(p + 4 * PITCH);
                bfr[j] = (bf16x8){lo[0], lo[1], lo[2], lo[3], hi[0], hi[1], hi[2], hi[3]}; }
#pragma unroll
            for (int mb = 0; mb < MB; ++mb) { const bf16x8 afr = *(const bf16x8*)(F + (mb * 16 + n) * 128 + ks * 32 + 8 * kq);
                acc[mb][0] = __builtin_amdgcn_mfma_f32_16x16x32_bf16(afr, bfr[0], acc[mb][0], 0, 0, 0);
                acc[mb][1] = __builtin_amdgcn_mfma_f32_16x16x32_bf16(afr, bfr[1], acc[mb][1], 0, 0, 0); }
        }
        if constexpr (STAGE == 1) {
#pragma unroll
            for (int mb = 0; mb < 4; ++mb)
#pragma unroll
                for (int jj = 0; jj < 4; ++jj) { const int k1 = mb * 16 + 4 * kq + jj; const float2 cs = TW[k1 * t];
                    bf16_t* orow = OUT + (((size_t)b * 64 + k1) * 64 + t) * 2048 + g * 512;
#pragma unroll
                    for (int j = 0; j < 2; ++j) { const float re = acc[mb][j][jj], im = acc[mb + 4][j][jj]; const int col = (2 * wid + j) * 16 + n;
                        orow[col] = (bf16_t)f2bf(re * cs.x + im * cs.y); orow[256 + col] = (bf16_t)f2bf(im * cs.x - re * cs.y); } }
        } else {
#pragma unroll
            for (int mb = 0; mb < 4; ++mb)
#pragma unroll
                for (int jj = 0; jj < 4; ++jj) { const int k2 = mb * 16 + 4 * kq + jj;
                    bf16_t* orow = OUT + ((size_t)b * 4096 + t + 64 * k2) * 1024 + g * 256;
#pragma unroll
                    for (int j = 0; j < 2; ++j) orow[(2 * wid + j) * 16 + n] = (bf16_t)f2bf(acc[mb][j][jj] * (1.f / 1024.f)); }
        }
        __syncthreads();
    }
}

#define FFN_LAYER(l) \
    if (SEC(1) && RUN) norm_mod_phase(a.out, nullptr, false, a.in[I_N2G] + (l) * DM, MOD + (size_t)(l) * 5 * 6144, 3, H, G, bx); \
    SEAM(); \
    if (RUN) { pg8::Gemm g{H, (const bf16_t*)(ws + WS_WUP) + (size_t)(l) * NUP * DM, DM, DM, DM, 30, 254, -1}; pg8::StaticOrder S; S.init_tiles(65, NUP / 256, G, bx); \
        pg8::EpiConvGate E{ACT, a.in[I_CW] + (size_t)(l) * 3 * NUP, a.in[I_CB] + (size_t)(l) * NUP}; if (SEC(2)) pg8::gemm_phase(lds, g, S, E); } \
    SEAM(); \
    if (RUN) { pg8::Gemm g{ACT, (const bf16_t*)(ws + WS_WDN) + (size_t)(l) * DM * FF, FF, FF, FF, 30, 256, 0}; pg8::StaticOrder S; S.init(ML, DM, G, bx); pg8::EpiResid E{a.out, a.out, MOD + (size_t)(l) * 5 * 6144 + 5 * 1024}; if (SEC(6)) pg8::gemm_phase(lds, g, S, E); } \
    SEAM();
constexpr int NPH = 10 + 4 * NCH + 10;
__global__ void __launch_bounds__(512, 2) fwd_kernel(Args a) {
    extern __shared__ __attribute__((aligned(16))) unsigned char lds_g[];
    LAS unsigned char* lds = (LAS unsigned char*)lds_g;
    const int G = gridDim.x, bx = blockIdx.x;
    const int vcu = (G % 8 == 0) ? (bx % 8) * (G / 8) + bx / 8 : bx;
    unsigned char* ws = a.ws;
    bf16_t* H = (bf16_t*)(ws + WS_H); bf16_t* QKV = (bf16_t*)(ws + WS_QKV); bf16_t* MIX = (bf16_t*)(ws + WS_MIX);
    bf16_t* ACT = (bf16_t*)(ws + WS_ACT);
    bf16_t* Z = (bf16_t*)(ws + WS_Z); bf16_t* A1 = (bf16_t*)(ws + WS_A1); bf16_t* Y = (bf16_t*)(ws + WS_Y);
    float* MOD = (float*)(ws + WS_MOD);
    const int lo = a.ph_lo, hi = a.ph_hi;
    int ph = 0;
    volatile LAS unsigned* xst = (volatile LAS unsigned*)(lds + LDS_BYTES - 16);
    if (threadIdx.x == 0) { xst[0] = 0u; xst[1] = 0u; }
    __syncthreads();
    const XcdBarrier xbar = xcd_barrier_post((unsigned*)(ws + WS_BAR), xst);
    if (hi < 0) cg::this_grid().sync();
#if MK_SPLIT
#define SEAM() do { ++ph; } while (0)
#else
#define SEAM() do { if (lo <= ph && ph + 1 < hi) xcd_barrier(xbar); ++ph; } while (0)
#endif
#define RUN (lo <= ph && ph < hi)


    if (SEC(0) && RUN) p0_prologue(a, lds, G, bx);
    SEAM();
    if (SEC(1) && RUN) norm_mod_phase(a.in[I_X], a.in[I_CTX], true, a.in[I_N1G], MOD, 0, H, G, bx);
    SEAM();
    if (RUN) { pg8::Gemm g{H, (const bf16_t*)(ws + WS_WIN), DM, DM, DM, 30, 256, 0}; pg8::StaticOrder S; S.init(MQ, NIN, G, bx); pg8::EpiStore E{QKV, NIN}; if (SEC(2)) pg8::gemm_phase(lds, g, S, E); }
    SEAM();
    if (SEC(3) && RUN) qknorm_phase(QKV, a.in[I_QG], a.in[I_KG], (const float2*)(ws + WS_ROPE), G, bx);
    SEAM();
    if ((SEC(4) || SEC(5)) && RUN) attention_phase(QKV, a.in[I_RPB], MIX, lds_g, lds, G, vcu);
    SEAM();
    if (RUN) { pg8::Gemm g{MIX, (const bf16_t*)(ws + WS_WO), DM, DM, DM, 30, 256, 0}; pg8::StaticOrder S; S.init(ML, DM, G, bx); pg8::EpiResid E{a.in[I_X], a.out, MOD + 2048}; if (SEC(6)) pg8::gemm_phase(lds, g, S, E); }
    SEAM();
    FFN_LAYER(0);
    if (SEC(1) && RUN) norm_mod_phase(a.out, nullptr, false, a.in[I_N1G] + DM, MOD + 5 * 6144, 0, H, G, bx);
    SEAM();
    if (RUN) { pg8::Gemm g{H, (const bf16_t*)(ws + WS_DFTC), DM, 256, 256, 1, 256, 0}; pg8::StaticOrder S; S.init(ML, 2048, G, bx); pg8::EpiStore E{Z, 2048}; if (SEC(2)) pg8::gemm_phase(lds, g, S, E); }
    SEAM();
    if (SEC(7) && RUN) fft_phase<1>(Z, A1, (const bf16_t*)(ws + WS_F1), (const float2*)(ws + WS_TW), lds, G, bx);
    SEAM();
    if (SEC(7) && RUN) fft_phase<2>(A1, Y, (const bf16_t*)(ws + WS_F2), (const float2*)(ws + WS_TW), lds, G, bx);
    SEAM();
    if (RUN) { pg8::Gemm g{Y, (const bf16_t*)(ws + WS_WF), DM, DM, DM, 30, 256, 0}; pg8::StaticOrder S; S.init(ML, DM, G, bx); pg8::EpiResid E{a.out, a.out, MOD + 5 * 6144 + 2048}; if (SEC(6)) pg8::gemm_phase(lds, g, S, E); }
    SEAM();
    FFN_LAYER(1);
    if (SEC(9) && RUN) final_norm_phase(a.out, a.in[I_FG], G, bx);
#undef SEAM
#undef RUN
}

extern "C" void kernel_launch(void* const* d_in, const int* in_sizes, int n_in, void* d_out, int out_size, void* d_ws, size_t ws_size, hipStream_t stream) {
    static int grid = 0;
    if (grid == 0) {
        if (n_in != 19 || in_sizes[0] != ML * DM || out_size != ML * DM || ws_size < WS_END) { fprintf(stderr, "kernel_launch: unexpected shapes (n_in %d, in0 %d, out %d, ws %zu < %zu)\n", n_in, n_in > 0 ? in_sizes[0] : -1, out_size, ws_size, (size_t)WS_END); grid = -1; return; }
        int dev = 0, cus = 0, per_cu = 0;
        hipGetDevice(&dev);
        hipDeviceGetAttribute(&cus, hipDeviceAttributeMultiprocessorCount, dev);
        if (hipFuncSetAttribute((const void*)fwd_kernel, hipFuncAttributeMaxDynamicSharedMemorySize, LDS_BYTES) != hipSuccess) { fprintf(stderr, "kernel_launch: hipFuncSetAttribute failed\n"); grid = -1; return; }
        if (hipOccupancyMaxActiveBlocksPerMultiprocessor(&per_cu, (const void*)fwd_kernel, 512, LDS_BYTES) != hipSuccess || per_cu < 1) { fprintf(stderr, "kernel_launch: occupancy query says %d\n", per_cu); per_cu = 1; }
        (void)hipGetLastError();
        grid = cus * (per_cu > 1 ? 1 : per_cu);
        if (grid <= 0) grid = 256;
    }
    if (grid < 0) return;
    Args a{};
    for (int i = 0; i < 19; ++i) a.in[i] = (const float*)d_in[i];
    a.out = (float*)d_out; a.ws = (unsigned char*)d_ws;
#if MK_SPLIT
    for (int p = 0; p < NPH + 2; ++p) { a.ph_lo = p; a.ph_hi = p + 1; hipLaunchKernelGGL(fwd_kernel, dim3(grid), dim3(512), LDS_BYTES, stream, a); }
#else
    a.ph_lo = 0; a.ph_hi = 1000;
    if (hipMemsetAsync((char*)d_ws + WS_BAR, 0, 16384, stream) != hipSuccess) { fprintf(stderr, "kernel_launch: memset failed\n"); return; }
    void* args[] = {&a};
    hipError_t e = hipLaunchCooperativeKernel((const void*)fwd_kernel, dim3(grid), dim3(512), args, LDS_BYTES, stream);
    if (e != hipSuccess) fprintf(stderr, "kernel_launch: cooperative launch failed: %s (grid %d)\n", hipGetErrorString(e), grid);
#endif
}
```
